# Optimizing an MI355X kernel written in HIP

```python
import math
import jax, jax.numpy as jnp
from jax import lax
import numpy as np

D_MODEL = 1024
BATCH = 8
SEQ = 2048
DEPTH = 1
DEC_BATCH = 128
DEC_SEQ = 8
PAST_LEN = 16384
PAGE_SIZE = 128

MIX_WIDTH = D_MODEL
RET_HEADS = 4
RET_DK = (MIX_WIDTH // 2) // RET_HEADS
RET_DV = RET_DK
RET_W = RET_HEADS * RET_DK
HG_HEADS = 4
HG_DK = (MIX_WIDTH - RET_W) // HG_HEADS
HG_DV = HG_DK
HG_W = HG_HEADS * HG_DK
IN_COLS = 4 * RET_W + 4 * HG_W
D_FF = 4 * D_MODEL
CHUNK = 64
ROPE_BASE = 10000.0
NORM_EPS = 1e-6

kernel_name = "retnet_hgrn2_parallel_heads_step"


def rmsnorm(x, w):
    xf = x.astype(jnp.float32)
    r = xf * lax.rsqrt(jnp.mean(xf * xf, axis=-1, keepdims=True) + NORM_EPS)
    return (r * w.astype(jnp.float32)).astype(x.dtype)


def head_rmsnorm(o, w):
    return o * lax.rsqrt(jnp.mean(o * o, axis=-1, keepdims=True) + NORM_EPS) * w.astype(jnp.float32)


def rotary(x, pos):
    half = x.shape[-1] // 2
    inv_freq = ROPE_BASE ** (-jnp.arange(half, dtype=jnp.float32) / half)
    ang = pos.astype(jnp.float32)[:, None] * inv_freq[None, :]
    cos = jnp.cos(ang)[None, :, None, :]
    sin = jnp.sin(ang)[None, :, None, :]
    xf = x.astype(jnp.float32)
    x1, x2 = xf[..., :half], xf[..., half:]
    return jnp.concatenate([x1 * cos - x2 * sin, x1 * sin + x2 * cos], axis=-1)


def chunk_gla(q, k, v, log_g, s0):
    B, T, H, dk = q.shape
    dv = v.shape[-1]
    C = math.gcd(T, CHUNK)
    n = T // C

    def to_chunks(a):
        return a.astype(jnp.float32).reshape(B, n, C, H, a.shape[-1]).transpose(1, 0, 3, 2, 4)

    qc, kc, vc, gc = to_chunks(q), to_chunks(k), to_chunks(v), to_chunks(log_g)
    causal = jnp.tril(jnp.ones((C, C), dtype=bool))
    scalar_decay = log_g.shape[-1] == 1

    def step(S, inp):
        qb, kb, vb, gb = inp
        b = jnp.cumsum(gb, axis=2)
        b_last = b[:, :, -1:, :]
        if scalar_decay:
            diff = b[:, :, :, None, 0] - b[:, :, None, :, 0]
            decay = jnp.exp(jnp.where(causal, diff, -jnp.inf))
            A = jnp.einsum('bhtd,bhsd->bhts', qb, kb) * decay
        else:
            diff = b[:, :, :, None, :] - b[:, :, None, :, :]
            decay = jnp.exp(jnp.where(causal[:, :, None], diff, -jnp.inf))
            A = jnp.einsum('bhtd,bhsd,bhtsd->bhts', qb, kb, decay)
        o = jnp.einsum('bhts,bhsv->bhtv', A, vb) + jnp.einsum('bhtd,bhdv->bhtv', qb * jnp.exp(b), S)
        k_dec = kb * jnp.exp(b_last - b)
        S_new = S * jnp.exp(b_last[:, :, 0, :])[..., None] + jnp.einsum('bhsd,bhsv->bhdv', k_dec, vb)
        return S_new, o

    S_fin, oc = lax.scan(step, s0.astype(jnp.float32), (qc, kc, vc, gc))
    o = oc.transpose(1, 0, 3, 2, 4).reshape(B, T, H, dv)
    return o, S_fin


def mixer(h, pos, s_ret, s_hg, w_in, ret_norm_w, hgrn_norm_w, lb, w_out):
    B, T, _ = h.shape
    proj = h @ w_in
    sizes = [RET_W] * 4 + [HG_W] * 4
    idx = [int(s) for s in np.cumsum(sizes)[:-1]]
    rq, rk, rv, rg, hq, hf, hi, hg = jnp.split(proj, idx, axis=-1)

    rq = rotary(rq.reshape(B, T, RET_HEADS, RET_DK), pos)
    rk = rotary(rk.reshape(B, T, RET_HEADS, RET_DK), pos) * (RET_DK ** -0.5)
    rv = rv.reshape(B, T, RET_HEADS, RET_DV)
    log_gamma = jnp.log(1.0 - 2.0 ** (-5.0 - jnp.arange(RET_HEADS, dtype=jnp.float32)))
    log_g_ret = jnp.broadcast_to(log_gamma[None, None, :, None], (B, T, RET_HEADS, 1))
    o_r, s_ret_new = chunk_gla(rq, rk, rv, log_g_ret, s_ret)
    gate_r = jax.nn.silu(rg.astype(jnp.float32)).reshape(B, T, RET_HEADS, RET_DV)
    o_r = (head_rmsnorm(o_r, ret_norm_w) * gate_r).reshape(B, T, RET_W)

    hq = jax.nn.silu(hq.astype(jnp.float32)).reshape(B, T, HG_HEADS, HG_DK) * (HG_DK ** -0.5)
    lb_h = lb.reshape(HG_HEADS, HG_DK)
    f = lb_h + (1.0 - lb_h) * jax.nn.sigmoid(hf.astype(jnp.float32).reshape(B, T, HG_HEADS, HG_DK))
    log_f = jnp.log(f)
    k_in = 1.0 - f
    v_in = hi.reshape(B, T, HG_HEADS, HG_DV)
    o_h, s_hg_new = chunk_gla(hq, k_in, v_in, log_f, s_hg)
    gate_h = jax.nn.silu(hg.astype(jnp.float32)).reshape(B, T, HG_HEADS, HG_DV)
    o_h = (head_rmsnorm(o_h, hgrn_norm_w) * gate_h).reshape(B, T, HG_W)

    o = jnp.concatenate([o_r, o_h], axis=-1).astype(h.dtype)
    return o @ w_out, s_ret_new, s_hg_new


def setup_inputs(seed: int = 0) -> dict:
    key = jax.random.key(seed)
    ks = jax.random.split(key, 16)
    f32 = jnp.float32
    nrm = lambda k, shape, s: jax.random.normal(k, shape, f32) * s
    return {
        "x_prompt": nrm(ks[0], (BATCH, SEQ, D_MODEL), 1.0),
        "x_sample": nrm(ks[1], (DEC_BATCH, DEC_SEQ, D_MODEL), 1.0),
        "state_ret": nrm(ks[2], (DEPTH, DEC_BATCH, RET_HEADS, RET_DK, RET_DV), 0.3),
        "state_hgrn": nrm(ks[3], (DEPTH, DEC_BATCH, HG_HEADS, HG_DK, HG_DV), 0.3),
        "norm_mix_w": 1.0 + nrm(ks[4], (DEPTH, D_MODEL), 0.02),
        "w_in": nrm(ks[5], (DEPTH, D_MODEL, IN_COLS), D_MODEL ** -0.5),
        "ret_norm_w": 1.0 + nrm(ks[6], (DEPTH, RET_DV), 0.02),
        "hgrn_norm_w": 1.0 + nrm(ks[7], (DEPTH, HG_DV), 0.02),
        "lb_logits": nrm(ks[8], (DEPTH + 1, HG_W), 0.5),
        "w_out": nrm(ks[9], (DEPTH, MIX_WIDTH, D_MODEL), MIX_WIDTH ** -0.5),
        "norm_ffn_w": 1.0 + nrm(ks[10], (DEPTH, D_MODEL), 0.02),
        "w_up": nrm(ks[11], (DEPTH, D_MODEL, D_FF), D_MODEL ** -0.5),
        "w_down": nrm(ks[12], (DEPTH, D_FF, D_MODEL), D_FF ** -0.5),
        "final_norm_w": 1.0 + nrm(ks[13], (D_MODEL,), 0.02),
    }


def reference(x_prompt, x_sample, state_ret, state_hgrn, norm_mix_w, w_in, ret_norm_w, hgrn_norm_w,
              lb_logits, w_out, norm_ffn_w, w_up, w_down, final_norm_w):
    lb_all = jnp.cumsum(jax.nn.softmax(lb_logits.astype(jnp.float32), axis=0), axis=0)
    pos_p = jnp.arange(SEQ, dtype=jnp.int32)
    pos_s = PAST_LEN + jnp.arange(DEC_SEQ, dtype=jnp.int32)
    zero_ret = jnp.zeros((BATCH, RET_HEADS, RET_DK, RET_DV), jnp.float32)
    zero_hg = jnp.zeros((BATCH, HG_HEADS, HG_DK, HG_DV), jnp.float32)

    xp, xs = x_prompt, x_sample
    ret_p, hg_p, ret_s, hg_s = [], [], [], []
    for l in range(DEPTH):
        hp = rmsnorm(xp, norm_mix_w[l])
        mp, sr_p, sh_p = mixer(hp, pos_p, zero_ret, zero_hg, w_in[l], ret_norm_w[l], hgrn_norm_w[l], lb_all[l], w_out[l])
        hs = rmsnorm(xs, norm_mix_w[l])
        ms, sr_s, sh_s = mixer(hs, pos_s, state_ret[l], state_hgrn[l], w_in[l], ret_norm_w[l], hgrn_norm_w[l], lb_all[l], w_out[l])
        xp = xp + mp
        xs = xs + ms
        hp = rmsnorm(xp, norm_ffn_w[l])
        xp = xp + jnp.square(jax.nn.relu(hp @ w_up[l])) @ w_down[l]
        hs = rmsnorm(xs, norm_ffn_w[l])
        xs = xs + jnp.square(jax.nn.relu(hs @ w_up[l])) @ w_down[l]
        ret_p.append(sr_p.astype(x_prompt.dtype))
        hg_p.append(sh_p.astype(x_prompt.dtype))
        ret_s.append(sr_s.astype(state_ret.dtype))
        hg_s.append(sh_s.astype(state_hgrn.dtype))

    y_prompt = rmsnorm(xp, final_norm_w)
    y_sample = rmsnorm(xs, final_norm_w)
    ret_state_prompt = jnp.stack(ret_p, axis=0)
    hgrn_state_prompt = jnp.stack(hg_p, axis=0)
    ret_state_sample = jnp.stack(ret_s, axis=0)
    hgrn_state_sample = jnp.stack(hg_s, axis=0)
    return (y_prompt, y_sample, ret_state_prompt, hgrn_state_prompt, ret_state_sample, hgrn_state_sample)
```

```cpp
#include <hip/hip_runtime.h>
#include <hip/hip_cooperative_groups.h>
#include <cstdio>
#include <cstdint>
namespace cg = cooperative_groups;
namespace pg8 {
#define PG8_LAS __attribute__((address_space(3)))
typedef unsigned short bf16_t;
typedef short bf16x8 __attribute__((ext_vector_type(8)));
typedef float f32x4 __attribute__((ext_vector_type(4)));
typedef unsigned u32x4 __attribute__((ext_vector_type(4)));
constexpr int BM = 256, BK = 64, HALF = 128, HTB = HALF * BK * 2  , STAGE_BYTES = 8 * HTB, NXCD = 8, WGM = 8;

__host__ __device__ __forceinline__ int lds_byte(int r, int c) { const int st = (r >> 4) * 2 + (c >> 5), rr = r & 15, cc = c & 31, ob = rr * 64 + cc * 2; return st * 1024 + (ob ^ (((ob >> 9) & 1) << 5)); }
__host__ __device__ __forceinline__ void stage_rc(int b, int& R, int& C) { const int st = b / 1024, sb = b % 1024, swz = sb ^ (((sb >> 9) & 1) << 5); R = (st >> 1) * 16 + swz / 64; C = (st & 1) * 32 + (swz % 64) / 2; }
__host__ __device__ __forceinline__ int perm32(int rho) { const int n = rho >> 4, i = rho & 15; return 8 * (i >> 2) + 4 * n + (i & 3); }

struct Unit { int pm, pn; };
struct Gemm { const bf16_t* A; const bf16_t* Bt; int M, N, K; };

struct StaticOrder {
    int nM, nN, nwg, G, c;
    __host__ __device__ void init(int M, int N, int G_, int c_) { nM = M / BM; nN = N / BM; nwg = nM * nN; G = G_; c = c_; }
    __host__ __device__ bool next(int i, Unit& u) const {
        const long L = (long)i * G + c; if (L >= nwg) return false;
        int wgid = (int)L; { const int q = nwg / NXCD, r = nwg % NXCD, xcd = wgid % NXCD, off = wgid / NXCD; wgid = (xcd < r ? xcd * (q + 1) : r * (q + 1) + (xcd - r) * q) + off; }
        const int nig = WGM * nN, gid = wgid / nig, fm = gid * WGM, gsz = (nM - fm) < WGM ? (nM - fm) : WGM;
        u.pm = fm + ((wgid % nig) % gsz); u.pn = (wgid % nig) / gsz; return true;
    }
    __device__ __forceinline__ void a_ready(const Unit&) const {}
    __device__ __forceinline__ void done(const Unit&) const {}
};
__device__ __forceinline__ unsigned cvt_pk_bf16(float lo, float hi) { unsigned r; asm volatile("v_cvt_pk_bf16_f32 %0, %1, %2" : "=v"(r) : "v"(lo), "v"(hi)); return r; }
typedef float f32x2 __attribute__((ext_vector_type(2)));
template <class Epi, class Sched, bool ALIGN_EPI = false, bool SP2 = false>
__device__ __forceinline__ void gemm_phase(PG8_LAS unsigned char* lds, const Gemm g, const Sched& S, const Epi& E) {
    const int tid = threadIdx.x, wid = __builtin_amdgcn_readfirstlane(tid >> 6), lane = tid & 63, wr = wid >> 2, wc = wid & 3, fr = lane & 15, fq = lane >> 4;
    const int K = g.K, nt = K / BK;
    unsigned voffA[2], voffB[2];
#pragma unroll
    for (int i = 0; i < 2; ++i) { int R, C; stage_rc(tid * 16 + i * 8192, R, C); const int Rb = Epi::PERM ? ((R & ~31) + perm32(R & 31)) : R;
        voffA[i] = (unsigned)(R * K + C) * 2u; voffB[i] = (unsigned)(Rb * K + C) * 2u; }
    const size_t kstep = (size_t)(BK * 2);
    const size_t hstep = (size_t)HALF * K * 2;
    const size_t tstep = 2 * hstep;
    const unsigned ldsw = (unsigned)wid * 1024u;
    const int aoff = lds_byte(wr * 64 + fr, fq * 8), boff = lds_byte(wc * 32 + fr, fq * 8);
#define PG8_SA(b, h) (((b) * 2 + (h)) * HTB)
#define PG8_SB(b, h) ((4 + (b) * 2 + (h)) * HTB)
#define PG8_STAGE(bufoff, gbase, voff) do { _Pragma("unroll") for (int _i = 0; _i < 2; ++_i) \
        __builtin_amdgcn_global_load_lds((const unsigned*)((const char*)(gbase) + (voff)[_i]), (PG8_LAS unsigned*)(lds + (bufoff) + ldsw + _i * 8192), 16, 0, 0); } while (0)
#define PG8_LDA(dst, b, h) do { _Pragma("unroll") for (int m = 0; m < 4; ++m) _Pragma("unroll") for (int k = 0; k < 2; ++k) dst[m][k] = *(const PG8_LAS bf16x8*)(lds + PG8_SA(b, h) + aoff + m * 2048 + k * 1024); } while (0)
#define PG8_LDB(dst, b, h) do { _Pragma("unroll") for (int n = 0; n < 2; ++n) _Pragma("unroll") for (int k = 0; k < 2; ++k) dst[n][k] = *(const PG8_LAS bf16x8*)(lds + PG8_SB(b, h) + boff + n * 2048 + k * 1024); } while (0)
#define PG8_MMA(ai, bj, At, Bt) do { __builtin_amdgcn_s_setprio(1); _Pragma("unroll") for (int m = 0; m < 4; ++m) _Pragma("unroll") for (int n = 0; n < 2; ++n) _Pragma("unroll") for (int k = 0; k < 2; ++k) \
        acc[ai][bj][m][n] = __builtin_amdgcn_mfma_f32_16x16x32_bf16(Bt[n][k], At[m][k], acc[ai][bj][m][n], 0, 0, 0); __builtin_amdgcn_s_setprio(0); } while (0)
#define PG8_WAIT_V(n) asm volatile("s_waitcnt vmcnt(" #n ")" ::: "memory")
#define PG8_WAIT_L(n) asm volatile("s_waitcnt lgkmcnt(" #n ")" ::: "memory")
#define PG8_BAR __builtin_amdgcn_s_barrier()
#define PG8_SCHED __builtin_amdgcn_sched_barrier(0)
    Unit cur, nxt; int ui = 0;
    if (!S.next(0, cur)) return;
    f32x4 acc[2][2][4][2];
#pragma unroll
    for (int a = 0; a < 2; ++a)
#pragma unroll
        for (int b = 0; b < 2; ++b)
#pragma unroll
            for (int m = 0; m < 4; ++m)
#pragma unroll
                for (int n = 0; n < 2; ++n) acc[a][b][m][n] = (f32x4){0.f, 0.f, 0.f, 0.f};
    bf16x8 At[4][2], B0[2][2], B1[2][2];
    const char* cA = (const char*)g.A + (size_t)cur.pm * tstep; const char* cB = (const char*)g.Bt + (size_t)cur.pn * tstep;
    S.a_ready(cur);
    if constexpr (SP2) {
        PG8_STAGE(PG8_SB(0, 0), cB, voffB); PG8_STAGE(PG8_SB(0, 1), cB + hstep, voffB); PG8_STAGE(PG8_SA(0, 0), cA, voffA); PG8_STAGE(PG8_SA(0, 1), cA + hstep, voffA);
        if (wr == 1) PG8_BAR;
        PG8_WAIT_V(2); PG8_BAR;
        PG8_STAGE(PG8_SB(1, 0), cB + kstep, voffB); PG8_STAGE(PG8_SA(1, 0), cA + kstep, voffA); PG8_STAGE(PG8_SB(1, 1), cB + hstep + kstep, voffB);
        PG8_WAIT_V(6); PG8_BAR;
    } else {
        PG8_STAGE(PG8_SB(0, 0), cB, voffB); PG8_STAGE(PG8_SA(0, 0), cA, voffA); PG8_STAGE(PG8_SB(0, 1), cB + hstep, voffB); PG8_STAGE(PG8_SA(0, 1), cA + hstep, voffA);
        if (wr == 1) PG8_BAR;
        PG8_WAIT_V(4); PG8_BAR;
        PG8_STAGE(PG8_SB(1, 0), cB + kstep, voffB); PG8_STAGE(PG8_SA(1, 0), cA + kstep, voffA); PG8_STAGE(PG8_SB(1, 1), cB + hstep + kstep, voffB);
        PG8_WAIT_V(6); PG8_BAR;
    }
    for (;;) {
        const bool has_next = S.next(ui + 1, nxt);
        const char* nA = has_next ? (const char*)g.A + (size_t)nxt.pm * tstep : cA; const char* nB = has_next ? (const char*)g.Bt + (size_t)nxt.pn * tstep : cB;
        for (int t = 0; t < nt; t += 2) {
            const bool last = (t == nt - 2);
            const char* a1 = cA + (size_t)(t + 1) * kstep;
            const char* a2 = last ? nA : cA + (size_t)(t + 2) * kstep; const char* b2 = last ? nB : cB + (size_t)(t + 2) * kstep;
            const char* a3 = a2 + kstep; const char* b3 = b2 + kstep;
            if (last && has_next) S.a_ready(nxt);
            if constexpr (SP2) {
            PG8_LDB(B0, 0, 0); PG8_LDB(B1, 0, 1); PG8_SCHED; PG8_LDA(At, 0, 0); PG8_STAGE(PG8_SA(1, 1), a1 + hstep, voffA);
            PG8_WAIT_V(8); PG8_WAIT_L(0); PG8_BAR; PG8_MMA(0, 0, At, B0); PG8_MMA(0, 1, At, B1); PG8_BAR; PG8_SCHED;
            PG8_LDA(At, 0, 1); PG8_STAGE(PG8_SB(0, 0), b2, voffB); PG8_STAGE(PG8_SB(0, 1), b2 + hstep, voffB); PG8_STAGE(PG8_SA(0, 0), a2, voffA);
            PG8_WAIT_V(8); PG8_WAIT_L(0); PG8_BAR; PG8_MMA(1, 0, At, B0); PG8_MMA(1, 1, At, B1); PG8_BAR; PG8_SCHED;
            PG8_LDB(B0, 1, 0); PG8_LDB(B1, 1, 1); PG8_SCHED; PG8_LDA(At, 1, 0); PG8_STAGE(PG8_SA(0, 1), a2 + hstep, voffA);
            PG8_WAIT_V(8); PG8_WAIT_L(0); PG8_BAR; PG8_MMA(0, 0, At, B0); PG8_MMA(0, 1, At, B1); PG8_BAR; PG8_SCHED;
            PG8_LDA(At, 1, 1); PG8_STAGE(PG8_SB(1, 0), b3, voffB); PG8_STAGE(PG8_SB(1, 1), b3 + hstep, voffB); PG8_STAGE(PG8_SA(1, 0), a3, voffA);
            PG8_WAIT_V(8); PG8_WAIT_L(0); PG8_BAR; PG8_MMA(1, 0, At, B0); PG8_MMA(1, 1, At, B1); PG8_BAR; PG8_SCHED;
            } else {
            PG8_LDB(B0, 0, 0); PG8_SCHED; PG8_LDA(At, 0, 0); PG8_STAGE(PG8_SA(1, 1), a1 + hstep, voffA);
            PG8_WAIT_L(8); PG8_BAR; PG8_WAIT_L(0); PG8_MMA(0, 0, At, B0); PG8_BAR; PG8_SCHED;
            PG8_LDB(B1, 0, 1); PG8_STAGE(PG8_SB(0, 0), b2, voffB);
            PG8_BAR; PG8_WAIT_L(0); PG8_MMA(0, 1, At, B1); PG8_BAR;
            PG8_LDA(At, 0, 1); PG8_STAGE(PG8_SA(0, 0), a2, voffA);
            PG8_BAR; PG8_WAIT_L(0); PG8_MMA(1, 0, At, B0); PG8_BAR; PG8_SCHED;
            PG8_STAGE(PG8_SB(0, 1), b2 + hstep, voffB);
            PG8_WAIT_V(6); PG8_BAR; PG8_MMA(1, 1, At, B1); PG8_BAR;
            PG8_LDB(B0, 1, 0); PG8_SCHED; PG8_LDA(At, 1, 0); PG8_STAGE(PG8_SA(0, 1), a2 + hstep, voffA);
            PG8_WAIT_L(8); PG8_BAR; PG8_WAIT_L(0); PG8_MMA(0, 0, At, B0); PG8_BAR; PG8_SCHED;
            PG8_LDB(B1, 1, 1); PG8_STAGE(PG8_SB(1, 0), b3, voffB);
            PG8_BAR; PG8_WAIT_L(0); PG8_MMA(0, 1, At, B1); PG8_BAR;
            PG8_LDA(At, 1, 1); PG8_STAGE(PG8_SA(1, 0), a3, voffA);
            PG8_BAR; PG8_WAIT_L(0); PG8_MMA(1, 0, At, B0); PG8_BAR; PG8_SCHED;
            PG8_STAGE(PG8_SB(1, 1), b3 + hstep, voffB);
            PG8_WAIT_V(6); PG8_BAR; PG8_MMA(1, 1, At, B1); PG8_BAR;
            }
        }
        if constexpr (ALIGN_EPI) { if (wr == 0) PG8_BAR; }
        if constexpr (!Epi::AFTER_DRAIN) { E(acc, cur, wr, wc, fr, fq); S.done(cur); }
        if (!has_next) break;
#pragma unroll
        for (int a = 0; a < 2; ++a)
#pragma unroll
            for (int b = 0; b < 2; ++b)
#pragma unroll
                for (int m = 0; m < 4; ++m)
#pragma unroll
                    for (int n = 0; n < 2; ++n) acc[a][b][m][n] = (f32x4){0.f, 0.f, 0.f, 0.f};
        cur = nxt; cA = nA; cB = nB; ++ui;
        if constexpr (ALIGN_EPI) { if (wr == 1) PG8_BAR; }
    }
    PG8_WAIT_V(0);
    if constexpr (!ALIGN_EPI) { if (wr == 0) PG8_BAR; }
    PG8_BAR;
    if constexpr (Epi::AFTER_DRAIN) { E.fused(acc, cur, wr, wc, fr, fq, lds, wid, lane); S.done(cur); }
#undef PG8_SA
#undef PG8_SB
#undef PG8_STAGE
#undef PG8_LDA
#undef PG8_LDB
#undef PG8_MMA
#undef PG8_WAIT_V
#undef PG8_WAIT_L
#undef PG8_BAR
#undef PG8_SCHED
}
}

constexpr int D = 1024, NP = 16384, NS = 1024, M = NP + NS, NIN = 4096, FF = 4096, TP = 2048;
constexpr float EPS = 1e-6f;
constexpr int NWAVES = 8, NTHR = 512;
#ifndef MK_N_LAUNCHES
#define MK_N_LAUNCHES 1
#endif
constexpr int N_PHASES = 7;
constexpr size_t MiB = 1u << 20;
constexpr size_t WS_WIN = 1 * MiB, WS_WOUT = 9 * MiB, WS_WUP = 11 * MiB, WS_WDN = 19 * MiB, WS_TAB = 27 * MiB, WS_SSQ = 29 * MiB;
constexpr size_t WS_XN = 32 * MiB;
constexpr size_t WS_PROJ = 66 * MiB;
constexpr size_t WS_OB = 202 * MiB;
constexpr size_t WS_END = 236 * MiB;
constexpr size_t OUT_Y = 0, OUT_RSP = (size_t)M * D, OUT_HSP = OUT_RSP + 8 * 4 * 16384, OUT_RSS = OUT_HSP + 8 * 4 * 16384, OUT_HSS = OUT_RSS + (size_t)128 * 4 * 16384;
constexpr int LDS_BYTES = 147456;

#define LAS __attribute__((address_space(3)))
typedef unsigned short bf16;
typedef unsigned v4u __attribute__((ext_vector_type(4)));
typedef unsigned v2u __attribute__((ext_vector_type(2)));
typedef float f32x4 __attribute__((ext_vector_type(4)));
#define LDS_WAIT() asm volatile("s_waitcnt lgkmcnt(0)" ::: "memory")

__device__ __forceinline__ unsigned f2bf(float f) { unsigned u = __builtin_bit_cast(unsigned, f); return (u + 0x7fffu + ((u >> 16) & 1u)) >> 16; }
__device__ __forceinline__ unsigned pk2(float lo, float hi) { return f2bf(lo) | (f2bf(hi) << 16); }
__device__ __forceinline__ float bflo(unsigned u) { return __uint_as_float(u << 16); }
__device__ __forceinline__ float bfhi(unsigned u) { return __uint_as_float(u & 0xffff0000u); }
__device__ __forceinline__ float sigmoidf_(float x) { return __builtin_amdgcn_rcpf(1.0f + __expf(-x)); }
__device__ __forceinline__ float siluf_(float x) { return x * sigmoidf_(x); }
__device__ __forceinline__ float wave_sum(float v) {
#pragma unroll
    for (int o = 1; o < 64; o <<= 1) v += __shfl_xor(v, o);
    return v;
}
__device__ __forceinline__ float log2gamma(int h) { return h == 0 ? -0.04580368961312479f : (h == 1 ? -0.02272007650008353f : (h == 2 ? -0.011315313227834146f : -0.005646563141142063f)); }

__constant__ double INVF[64] = {1.0, 0.8659643233600653, 0.7498942093324559, 0.6493816315762113, 0.5623413251903491, 0.4869675251658631, 0.4216965034285822, 0.3651741272548377, 0.31622776601683794, 0.27384196342643613, 0.23713737056616552, 0.2053525026457146, 0.1778279410038923, 0.1539926526059492, 0.1333521432163324, 0.11547819846894582, 0.1, 0.08659643233600653, 0.07498942093324558, 0.06493816315762113, 0.05623413251903491, 0.04869675251658631, 0.042169650342858224, 0.03651741272548377, 0.03162277660168379, 0.027384196342643614, 0.023713737056616554, 0.02053525026457146, 0.01778279410038923, 0.01539926526059492, 0.01333521432163324, 0.011547819846894581, 0.01, 0.008659643233600654, 0.007498942093324558, 0.006493816315762113, 0.005623413251903491, 0.004869675251658631, 0.004216965034285823, 0.003651741272548377, 0.0031622776601683794, 0.0027384196342643613, 0.0023713737056616554, 0.002053525026457146, 0.0017782794100389228, 0.001539926526059492, 0.001333521432163324, 0.0011547819846894581, 0.001, 0.0008659643233600654, 0.0007498942093324559, 0.0006493816315762113, 0.0005623413251903491, 0.0004869675251658631, 0.00042169650342858224, 0.0003651741272548377, 0.00031622776601683794, 0.0002738419634264361, 0.00023713737056616554, 0.0002053525026457146, 0.00017782794100389227, 0.0001539926526059492, 0.0001333521432163324, 0.00011547819846894582};

using pg8::Unit;

struct EpiProj {
    static constexpr bool PERM = true, AFTER_DRAIN = false;
    bf16* P; const float* tab; const float* lbl;
    __device__ __forceinline__ void operator()(const f32x4 (&acc)[2][2][4][2], const Unit& u, int wr, int wc, int fr, int fq) const {
        const int type = u.pn >> 1;
        const int row0 = u.pm * 256 + wr * 64 + fr, d0 = wc * 32 + 8 * fq, col0 = u.pn * 256 + d0;
        if (type <= 1) {
#pragma unroll
            for (int ai = 0; ai < 2; ++ai)
#pragma unroll
                for (int m = 0; m < 4; ++m) {
                    const int row = row0 + ai * 128 + m * 16;
                    const int pidx = row < NP ? (row & (TP - 1)) : TP + (row & 7);
                    const f32x4* tp = (const f32x4*)(tab + ((size_t)pidx * 64 + (d0 >> 1)) * 2);
                    const f32x4 cs0 = tp[0], cs1 = tp[1];
                    bf16* rowp = P + (size_t)row * NIN + col0;
#pragma unroll
                    for (int bj = 0; bj < 2; ++bj) {
                        float sc = 1.0f;
                        if (type == 1) { sc = 0.08838834764831845f; if (row < NP) sc *= exp2f(-(float)((row & 63) + 1) * log2gamma(2 * (u.pn & 1) + bj)); }
                        const f32x4 v0 = acc[ai][bj][m][0], v1 = acc[ai][bj][m][1];
                        v4u w;
                        w.x = pk2((v0[0] * cs0[0] - v0[1] * cs0[1]) * sc, (v0[0] * cs0[1] + v0[1] * cs0[0]) * sc);
                        w.y = pk2((v0[2] * cs0[2] - v0[3] * cs0[3]) * sc, (v0[2] * cs0[3] + v0[3] * cs0[2]) * sc);
                        w.z = pk2((v1[0] * cs1[0] - v1[1] * cs1[1]) * sc, (v1[0] * cs1[1] + v1[1] * cs1[0]) * sc);
                        w.w = pk2((v1[2] * cs1[2] - v1[3] * cs1[3]) * sc, (v1[2] * cs1[3] + v1[3] * cs1[2]) * sc);
                        *(v4u*)(rowp + bj * 128) = w;
                    }
                    if (m & 1) asm volatile("" ::: "memory");
                }
        } else if (type == 5) {
            float lb[2][8];
#pragma unroll
            for (int bj = 0; bj < 2; ++bj)
#pragma unroll
                for (int i = 0; i < 8; ++i) { const int c = (u.pn & 1) * 256 + bj * 128 + d0 + i; lb[bj][i] = sigmoidf_(lbl[c] - lbl[512 + c]); }
#pragma unroll
            for (int ai = 0; ai < 2; ++ai)
#pragma unroll
                for (int m = 0; m < 4; ++m) {
                    const int row = row0 + ai * 128 + m * 16;
                    bf16* rowp = P + (size_t)row * NIN + col0;
#pragma unroll
                    for (int bj = 0; bj < 2; ++bj) {
                        float o[8];
#pragma unroll
                        for (int i = 0; i < 8; ++i) { const float x = acc[ai][bj][m][i >> 2][i & 3]; const float f = lb[bj][i] + (1.0f - lb[bj][i]) * sigmoidf_(x); o[i] = __logf(f); }
                        v4u w; w.x = pk2(o[0], o[1]); w.y = pk2(o[2], o[3]); w.z = pk2(o[4], o[5]); w.w = pk2(o[6], o[7]);
                        *(v4u*)(rowp + bj * 128) = w;
                    }
                }
        } else {
            const bool act = (type == 3) || (type == 4) || (type == 7);
            const float sc = (type == 4) ? 0.08838834764831845f : 1.0f;
#pragma unroll
            for (int ai = 0; ai < 2; ++ai)
#pragma unroll
                for (int m = 0; m < 4; ++m) {
                    const int row = row0 + ai * 128 + m * 16;
                    bf16* rowp = P + (size_t)row * NIN + col0;
#pragma unroll
                    for (int bj = 0; bj < 2; ++bj) {
                        float o[8];
#pragma unroll
                        for (int i = 0; i < 8; ++i) { const float x = acc[ai][bj][m][i >> 2][i & 3]; o[i] = act ? siluf_(x) * sc : x; }
                        v4u w; w.x = pk2(o[0], o[1]); w.y = pk2(o[2], o[3]); w.z = pk2(o[4], o[5]); w.w = pk2(o[6], o[7]);
                        *(v4u*)(rowp + bj * 128) = w;
                    }
                }
        }
    }
};

struct EpiOut {
    static constexpr bool PERM = true, AFTER_DRAIN = false;
    const float* xp; const float* xs; float* X1; bf16* X1B; float* ssq;
    __device__ __forceinline__ void operator()(const f32x4 (&acc)[2][2][4][2], const Unit& u, int wr, int wc, int fr, int fq) const {
        const int row0 = u.pm * 256 + wr * 64 + fr, col0 = u.pn * 256 + wc * 32 + 8 * fq;
#pragma unroll
        for (int ai = 0; ai < 2; ++ai)
#pragma unroll
            for (int m = 0; m < 4; ++m) {
                const int row = row0 + ai * 128 + m * 16;
                const float* xr = (row < NP ? xp + (size_t)row * D : xs + (size_t)(row - NP) * D) + col0;
                float* op = X1 + (size_t)row * D + col0; bf16* bp = X1B + (size_t)row * D + col0;
                float s = 0.f;
#pragma unroll
                for (int bj = 0; bj < 2; ++bj) {
                    const f32x4 v0 = acc[ai][bj][m][0] + *(const f32x4*)(xr + bj * 128), v1 = acc[ai][bj][m][1] + *(const f32x4*)(xr + bj * 128 + 4);
                    *(f32x4*)(op + bj * 128) = v0; *(f32x4*)(op + bj * 128 + 4) = v1;
                    v4u w; w.x = pk2(v0[0], v0[1]); w.y = pk2(v0[2], v0[3]); w.z = pk2(v1[0], v1[1]); w.w = pk2(v1[2], v1[3]);
                    *(v4u*)(bp + bj * 128) = w;
                    s += (v0[0] * v0[0] + v0[1] * v0[1]) + (v0[2] * v0[2] + v0[3] * v0[3]) + (v1[0] * v1[0] + v1[1] * v1[1]) + (v1[2] * v1[2] + v1[3] * v1[3]);
                }
                s += __shfl_xor(s, 16); s += __shfl_xor(s, 32);
                if (fq == 0) ssq[(size_t)row * 16 + u.pn * 4 + wc] = s;
                if (m & 1) asm volatile("" ::: "memory");
            }
    }
};

struct EpiUp {
    static constexpr bool PERM = true, AFTER_DRAIN = false;
    bf16* H; const float* ssq;
    __device__ __forceinline__ void operator()(const f32x4 (&acc)[2][2][4][2], const Unit& u, int wr, int wc, int fr, int fq) const {
        const int row0 = u.pm * 256 + wr * 64 + fr, col0 = u.pn * 256 + wc * 32 + 8 * fq;
#pragma unroll
        for (int ai = 0; ai < 2; ++ai)
#pragma unroll
            for (int m = 0; m < 4; ++m) {
                const int row = row0 + ai * 128 + m * 16;
                const f32x4* sp = (const f32x4*)(ssq + (size_t)row * 16);
                const f32x4 a = sp[0], b = sp[1], c = sp[2], d = sp[3];
                const float ss = ((a[0] + a[1]) + (a[2] + a[3])) + ((b[0] + b[1]) + (b[2] + b[3])) + ((c[0] + c[1]) + (c[2] + c[3])) + ((d[0] + d[1]) + (d[2] + d[3]));
                const float r2 = 1.0f / (ss * (1.0f / D) + EPS);
                bf16* hp = H + (size_t)row * FF + col0;
#pragma unroll
                for (int bj = 0; bj < 2; ++bj) {
                    float o[8];
#pragma unroll
                    for (int i = 0; i < 8; ++i) { const float x = fmaxf(acc[ai][bj][m][i >> 2][i & 3], 0.f); o[i] = x * x * r2; }
                    v4u w; w.x = pk2(o[0], o[1]); w.y = pk2(o[2], o[3]); w.z = pk2(o[4], o[5]); w.w = pk2(o[6], o[7]);
                    *(v4u*)(hp + bj * 128) = w;
                }
                if (m & 1) asm volatile("" ::: "memory");
            }
    }
};

struct EpiDown {
    static constexpr bool PERM = true, AFTER_DRAIN = false;
    float* X;
    __device__ __forceinline__ void operator()(const f32x4 (&acc)[2][2][4][2], const Unit& u, int wr, int wc, int fr, int fq) const {
        const int row0 = u.pm * 256 + wr * 64 + fr, col0 = u.pn * 256 + wc * 32 + 8 * fq;
#pragma unroll
        for (int ai = 0; ai < 2; ++ai)
#pragma unroll
            for (int m = 0; m < 4; ++m) {
                float* op = X + (size_t)(row0 + ai * 128 + m * 16) * D + col0;
#pragma unroll
                for (int bj = 0; bj < 2; ++bj) {
                    const f32x4 v0 = acc[ai][bj][m][0] + *(const f32x4*)(op + bj * 128), v1 = acc[ai][bj][m][1] + *(const f32x4*)(op + bj * 128 + 4);
                    *(f32x4*)(op + bj * 128) = v0; *(f32x4*)(op + bj * 128 + 4) = v1;
                }
                if (m & 1) asm volatile("" ::: "memory");
            }
    }
};

__device__ __forceinline__ int wmap_in(int n) { if (n < 1024) { const int d = n & 127; return (n & ~127) | ((d & 63) << 1) | (d >> 6); } return n; }
template <bool MAP>
__device__ __forceinline__ void p0_transpose_item(const float* W, int K, int N, bf16* WT, const float* kscale, LAS float* scr, int item, int lane) {
    const int nblk = N / 32, kb = item / nblk, nb = item % nblk, k0 = 64 * kb, n0 = 32 * nb;
#pragma unroll 8
    for (int i = 0; i < 32; ++i) { const int kk = 2 * i + (lane >> 5); float w = W[(size_t)(k0 + kk) * N + n0 + (lane & 31)]; if (kscale) w *= kscale[k0 + kk]; scr[kk * 33 + (lane & 31)] = w; }
    LDS_WAIT(); asm volatile("" ::: "memory");
    const int c = lane & 7;
#pragma unroll
    for (int j = 0; j < 4; ++j) { const int n = (lane >> 3) + 8 * j; const LAS float* s = scr + (8 * c) * 33 + n;
        v4u o; o.x = pk2(s[0 * 33], s[1 * 33]); o.y = pk2(s[2 * 33], s[3 * 33]); o.z = pk2(s[4 * 33], s[5 * 33]); o.w = pk2(s[6 * 33], s[7 * 33]);
        const int nd = MAP ? wmap_in(n0 + n) : (n0 + n);
        *(v4u*)(WT + (size_t)nd * K + k0 + 8 * c) = o; }
    LDS_WAIT(); asm volatile("" ::: "memory");
}
__device__ __forceinline__ void rms_row_to_bf16(const float* xrow, const float* w, bf16* orow, int lane) {
    const f32x4* xr = (const f32x4*)xrow + lane; const f32x4* wr_ = (const f32x4*)w + lane;
    f32x4 v[4]; float s = 0.f;
#pragma unroll
    for (int j = 0; j < 4; ++j) { v[j] = xr[64 * j]; s += (v[j][0] * v[j][0] + v[j][1] * v[j][1]) + (v[j][2] * v[j][2] + v[j][3] * v[j][3]); }
    const float rstd = rsqrtf(wave_sum(s) * (1.f / D) + EPS);
    unsigned long long* o8 = (unsigned long long*)orow + lane;
#pragma unroll
    for (int j = 0; j < 4; ++j) { const f32x4 ww = wr_[64 * j]; const f32x4 o = v[j] * rstd * ww; o8[64 * j] = (unsigned long long)pk2(o[0], o[1]) | ((unsigned long long)pk2(o[2], o[3]) << 32); }
}
__device__ __forceinline__ void rms_row_inplace(float* xrow, const float* w, int lane) {
    f32x4* xr = (f32x4*)xrow + lane; const f32x4* wr_ = (const f32x4*)w + lane;
    f32x4 v[4]; float s = 0.f;
#pragma unroll
    for (int j = 0; j < 4; ++j) { v[j] = xr[64 * j]; s += (v[j][0] * v[j][0] + v[j][1] * v[j][1]) + (v[j][2] * v[j][2] + v[j][3] * v[j][3]); }
    const float rstd = rsqrtf(wave_sum(s) * (1.f / D) + EPS);
#pragma unroll
    for (int j = 0; j < 4; ++j) xr[64 * j] = v[j] * rstd * wr_[64 * j];
}

template <bool HG>
__device__ __forceinline__ void rec_unit(LAS unsigned char* lds, const bf16* proj, bf16* OB, const float* normw, size_t row0, int T, int h, bool prompt, const float* s_in, float* s_out, int tid) {
    const int w = __builtin_amdgcn_readfirstlane(tid >> 6), lane = tid & 63, dq = lane >> 2, vq = lane & 3;
    const int colq = (HG ? 2048 : 0) + 128 * h, colk = colq + 512, colv = colq + 1024, colg = colq + 1536, colo = (HG ? 512 : 0) + 128 * h;
    LAS bf16* Qs = (LAS bf16*)lds; LAS bf16* Ks = Qs + 64 * 128; LAS bf16* Vs = Ks + 64 * 128; LAS float* Os = (LAS float*)(lds + 49152);
    float S[8][4];
    const int vcol = 16 * w + 4 * vq;
#pragma unroll
    for (int i = 0; i < 8; ++i) { const int p = 8 * dq + i, d = HG ? p : ((p >> 1) + 64 * (p & 1));
        if (s_in) { const f32x4 t = *(const f32x4*)(s_in + (size_t)d * 128 + vcol); S[i][0] = t[0]; S[i][1] = t[1]; S[i][2] = t[2]; S[i][3] = t[3]; }
        else { S[i][0] = 0.f; S[i][1] = 0.f; S[i][2] = 0.f; S[i][3] = 0.f; } }
    const float l2g = log2gamma(h), gam = exp2f(l2g);
    for (int t0 = 0; t0 < T; t0 += 64) {
        const int TC = (T - t0) < 64 ? (T - t0) : 64;
        __syncthreads();
        for (int i = tid; i < TC * 16; i += NTHR) { const int r = i >> 4, c = i & 15; const bf16* src = proj + (row0 + t0 + r) * NIN + c * 8;
            *(LAS v4u*)(Qs + r * 128 + c * 8) = *(const v4u*)(src + colq); *(LAS v4u*)(Ks + r * 128 + c * 8) = *(const v4u*)(src + colk); *(LAS v4u*)(Vs + r * 128 + c * 8) = *(const v4u*)(src + colv); }
        __syncthreads();
        for (int t = 0; t < TC; ++t) {
            const v4u qu = *(const LAS v4u*)(Qs + t * 128 + 8 * dq), ku = *(const LAS v4u*)(Ks + t * 128 + 8 * dq); const v2u vu = *(const LAS v2u*)(Vs + t * 128 + vcol);
            float q[8], k[8], f[8], v[4];
            q[0] = bflo(qu.x); q[1] = bfhi(qu.x); q[2] = bflo(qu.y); q[3] = bfhi(qu.y); q[4] = bflo(qu.z); q[5] = bfhi(qu.z); q[6] = bflo(qu.w); q[7] = bfhi(qu.w);
            k[0] = bflo(ku.x); k[1] = bfhi(ku.x); k[2] = bflo(ku.y); k[3] = bfhi(ku.y); k[4] = bflo(ku.z); k[5] = bfhi(ku.z); k[6] = bflo(ku.w); k[7] = bfhi(ku.w);
            v[0] = bflo(vu.x); v[1] = bfhi(vu.x); v[2] = bflo(vu.y); v[3] = bfhi(vu.y);
            if (HG) {
#pragma unroll
                for (int i = 0; i < 8; ++i) { f[i] = __expf(k[i]); k[i] = 1.0f - f[i]; }
            } else {
                const float ks = prompt ? exp2f((float)(((t0 + t) & 63) + 1) * l2g) : 1.0f;
#pragma unroll
                for (int i = 0; i < 8; ++i) { f[i] = gam; k[i] *= ks; }
            }
            float o[4] = {0.f, 0.f, 0.f, 0.f};
#pragma unroll
            for (int i = 0; i < 8; ++i)
#pragma unroll
                for (int c = 0; c < 4; ++c) { S[i][c] = f[i] * S[i][c] + k[i] * v[c]; o[c] += q[i] * S[i][c]; }
#pragma unroll
            for (int c = 0; c < 4; ++c) { o[c] += __shfl_xor(o[c], 4); o[c] += __shfl_xor(o[c], 8); o[c] += __shfl_xor(o[c], 16); o[c] += __shfl_xor(o[c], 32); }
            if (dq == 0) *(LAS f32x4*)(Os + t * 128 + vcol) = (f32x4){o[0], o[1], o[2], o[3]};
        }
        __syncthreads();
        {
            const int r = tid >> 3, seg = tid & 7;
            if (r < TC) {
                float x[16]; float s = 0.f;
#pragma unroll
                for (int i = 0; i < 4; ++i) { const f32x4 t = *(const LAS f32x4*)(Os + r * 128 + seg * 16 + 4 * i); x[4 * i] = t[0]; x[4 * i + 1] = t[1]; x[4 * i + 2] = t[2]; x[4 * i + 3] = t[3]; s += (t[0] * t[0] + t[1] * t[1]) + (t[2] * t[2] + t[3] * t[3]); }
                s += __shfl_xor(s, 1); s += __shfl_xor(s, 2); s += __shfl_xor(s, 4);
                const float rstd = rsqrtf(s * (1.0f / 128.0f) + EPS);
                const bf16* gp = proj + (row0 + t0 + r) * NIN + colg + seg * 16;
                const v4u g0 = *(const v4u*)gp, g1 = *(const v4u*)(gp + 8);
                const unsigned gu[8] = {g0.x, g0.y, g0.z, g0.w, g1.x, g1.y, g1.z, g1.w};
                unsigned ou[8];
#pragma unroll
                for (int i = 0; i < 8; ++i) { const float a = x[2 * i] * rstd * normw[seg * 16 + 2 * i] * bflo(gu[i]), b = x[2 * i + 1] * rstd * normw[seg * 16 + 2 * i + 1] * bfhi(gu[i]); ou[i] = pk2(a, b); }
                bf16* op = OB + (row0 + t0 + r) * D + colo + seg * 16;
                *(v4u*)op = (v4u){ou[0], ou[1], ou[2], ou[3]}; *(v4u*)(op + 8) = (v4u){ou[4], ou[5], ou[6], ou[7]};
            }
        }
    }
#pragma unroll
    for (int i = 0; i < 8; ++i) { const int p = 8 * dq + i, d = HG ? p : ((p >> 1) + 64 * (p & 1)); *(f32x4*)(s_out + (size_t)d * 128 + vcol) = (f32x4){S[i][0], S[i][1], S[i][2], S[i][3]}; }
}

struct Args { const float* in[14]; float* out; unsigned char* ws; int ph_lo, ph_hi; };
__global__ void __launch_bounds__(NTHR, 2) mega_fwd(Args a) {
    extern __shared__ __attribute__((aligned(16))) unsigned char lds_raw[];
    LAS unsigned char* lds = (LAS unsigned char*)lds_raw;
    cg::grid_group grid = cg::this_grid();
    const int tid = threadIdx.x, lane = tid & 63, wave = __builtin_amdgcn_readfirstlane(tid >> 6);
    const int G = gridDim.x, bx = blockIdx.x;
    const float* x_p = a.in[0]; const float* x_s = a.in[1]; const float* st_ret = a.in[2]; const float* st_hg = a.in[3];
    const float* norm_mix_w = a.in[4]; const float* w_in = a.in[5]; const float* ret_norm_w = a.in[6]; const float* hg_norm_w = a.in[7];
    const float* lb_logits = a.in[8]; const float* w_out = a.in[9]; const float* norm_ffn_w = a.in[10]; const float* w_up = a.in[11]; const float* w_down = a.in[12];
    const float* final_norm_w = a.in[13];
    unsigned char* ws = a.ws; float* out = a.out;
    bf16* WinT = (bf16*)(ws + WS_WIN); bf16* WoutT = (bf16*)(ws + WS_WOUT); bf16* WupT = (bf16*)(ws + WS_WUP); bf16* WdnT = (bf16*)(ws + WS_WDN);
    float* tab = (float*)(ws + WS_TAB); float* ssq = (float*)(ws + WS_SSQ);
    bf16* XN = (bf16*)(ws + WS_XN); bf16* PROJ = (bf16*)(ws + WS_PROJ); bf16* HB = (bf16*)(ws + WS_PROJ); bf16* OB = (bf16*)(ws + WS_OB);
    const int lo = a.ph_lo, hi = a.ph_hi;
#define IN(k) (lo <= (k) && (k) < hi)
#define SEAM(k) do { if (IN(k) && IN((k) + 1)) grid.sync(); } while (0)

    if (IN(0)) {
        LAS float* scr = (LAS float*)(lds + wave * 16384);
        const int gw = bx * NWAVES + wave, NGW = G * NWAVES;
        constexpr int I_IN = (D / 64) * (NIN / 32), I_OUT = (D / 64) * (D / 32), I_UP = (D / 64) * (FF / 32), I_DN = (FF / 64) * (D / 32);
        for (int it = gw; it < I_IN + I_OUT + I_UP + I_DN; it += NGW) {
            int r = it;
            if (r < I_IN) { p0_transpose_item<true>(w_in, D, NIN, WinT, nullptr, scr, r, lane); continue; } r -= I_IN;
            if (r < I_OUT) { p0_transpose_item<false>(w_out, D, D, WoutT, nullptr, scr, r, lane); continue; } r -= I_OUT;
            if (r < I_UP) { p0_transpose_item<false>(w_up, D, FF, WupT, norm_ffn_w, scr, r, lane); continue; } r -= I_UP;
            p0_transpose_item<false>(w_down, FF, D, WdnT, nullptr, scr, r, lane);
        }
        for (int m = gw; m < M; m += NGW) rms_row_to_bf16(m < NP ? x_p + (size_t)m * D : x_s + (size_t)(m - NP) * D, norm_mix_w, XN + (size_t)m * D, lane);
        for (int i = bx * NTHR + tid; i < (TP + 8) * 64; i += G * NTHR) {
            const int pi = i >> 6, j = i & 63; const double pos = (double)(pi < TP ? pi : 16384 + (pi - TP));
            double t = pos * INVF[j] * 0.15915494309189535; t -= __builtin_rint(t);
            tab[2 * i] = __builtin_amdgcn_cosf((float)t); tab[2 * i + 1] = __builtin_amdgcn_sinf((float)t);
        }
    }
    SEAM(0);
    if (IN(1)) {
        pg8::Gemm g{XN, WinT, M, NIN, D}; pg8::StaticOrder S; S.init(M, NIN, G, bx);
        EpiProj E{PROJ, tab, lb_logits};
        pg8::gemm_phase<EpiProj, pg8::StaticOrder, true, true>(lds, g, S, E);
    }
    SEAM(1);
    if (IN(2)) {
        if (bx < 64) {
            const int b = bx >> 3, hd = bx & 7; const size_t row0 = (size_t)b * TP;
            if (hd < 4) rec_unit<false>(lds, PROJ, OB, ret_norm_w, row0, TP, hd, true, nullptr, out + OUT_RSP + (size_t)(b * 4 + hd) * 16384, tid);
            else rec_unit<true>(lds, PROJ, OB, hg_norm_w, row0, TP, hd - 4, true, nullptr, out + OUT_HSP + (size_t)(b * 4 + hd - 4) * 16384, tid);
        } else {
            for (int u = bx - 64; u < 1024; u += G - 64) {
                const int b = u >> 3, hd = u & 7; const size_t row0 = (size_t)NP + (size_t)b * 8;
                if (hd < 4) rec_unit<false>(lds, PROJ, OB, ret_norm_w, row0, 8, hd, false, st_ret + (size_t)(b * 4 + hd) * 16384, out + OUT_RSS + (size_t)(b * 4 + hd) * 16384, tid);
                else rec_unit<true>(lds, PROJ, OB, hg_norm_w, row0, 8, hd - 4, false, st_hg + (size_t)(b * 4 + hd - 4) * 16384, out + OUT_HSS + (size_t)(b * 4 + hd - 4) * 16384, tid);
            }
        }
    }
    SEAM(2);
    if (IN(3)) {
        pg8::Gemm g{OB, WoutT, M, D, D}; pg8::StaticOrder S; S.init(M, D, G, bx);
        EpiOut E{x_p, x_s, out + OUT_Y, XN, ssq};
        pg8::gemm_phase<EpiOut, pg8::StaticOrder, true, true>(lds, g, S, E);
    }
    SEAM(3);
    if (IN(4)) {
        pg8::Gemm g{XN, WupT, M, FF, D}; pg8::StaticOrder S; S.init(M, FF, G, bx);
        EpiUp E{HB, ssq};
        pg8::gemm_phase<EpiUp, pg8::StaticOrder, true, true>(lds, g, S, E);
    }
    SEAM(4);
    if (IN(5)) {
        pg8::Gemm g{HB, WdnT, M, D, FF}; pg8::StaticOrder S; S.init(M, D, G, bx);
        EpiDown E{out + OUT_Y};
        pg8::gemm_phase<EpiDown, pg8::StaticOrder, true, true>(lds, g, S, E);
    }
    SEAM(5);
    if (IN(6)) {
        const int gw = bx * NWAVES + wave, NGW = G * NWAVES;
        for (int m = gw; m < M; m += NGW) rms_row_inplace(out + OUT_Y + (size_t)m * D, final_norm_w, lane);
    }
#undef IN
#undef SEAM
}

extern "C" void kernel_launch(void* const* d_in, const int* in_sizes, int n_in, void* d_out, int out_size, void* d_ws, size_t ws_size, hipStream_t stream) {
    static int grid = 0;
    if (grid == 0) {
        if (n_in != 14 || in_sizes[0] != NP * D || ws_size < WS_END) { fprintf(stderr, "kernel_launch: unexpected shapes (n_in %d, in0 %d, ws %zu)\n", n_in, n_in > 0 ? in_sizes[0] : -1, ws_size); grid = -1; return; }
        int dev = 0, cus = 0, per_cu = 0;
        if (hipGetDevice(&dev) != hipSuccess || hipDeviceGetAttribute(&cus, hipDeviceAttributeMultiprocessorCount, dev) != hipSuccess) { grid = -1; return; }
        if (hipFuncSetAttribute((const void*)mega_fwd, hipFuncAttributeMaxDynamicSharedMemorySize, LDS_BYTES) != hipSuccess) { fprintf(stderr, "kernel_launch: hipFuncSetAttribute failed\n"); grid = -1; return; }
        if (hipOccupancyMaxActiveBlocksPerMultiprocessor(&per_cu, (const void*)mega_fwd, NTHR, LDS_BYTES) != hipSuccess || per_cu < 1) { fprintf(stderr, "kernel_launch: occupancy query says %d blocks per CU\n", per_cu); (void)hipGetLastError(); grid = -1; return; }
        grid = cus;
        if (grid < 128) { fprintf(stderr, "kernel_launch: needs >= 128 CUs\n"); grid = -1; return; }
    }
    if (grid < 0) return;
    Args a{};
    for (int i = 0; i < 14; ++i) a.in[i] = (const float*)d_in[i];
    a.out = (float*)d_out; a.ws = (unsigned char*)d_ws;
#if MK_N_LAUNCHES == 1
    a.ph_lo = 0; a.ph_hi = N_PHASES;
    void* args[] = {&a};
    hipError_t e = hipLaunchCooperativeKernel((const void*)mega_fwd, dim3(grid), dim3(NTHR), args, LDS_BYTES, stream);
    if (e != hipSuccess) fprintf(stderr, "cooperative launch failed: %s (grid %d)\n", hipGetErrorString(e), grid);
#else
    for (int p = 0; p < N_PHASES; ++p) { a.ph_lo = p; a.ph_hi = p + 1; hipLaunchKernelGGL(mega_fwd, dim3(grid), dim3(NTHR), LDS_BYTES, stream, a); }
#endif
}
```

```cpp
#include <hip/hip_runtime.h>
#include <hip/hip_cooperative_groups.h>
#include <cstdio>
#include <cstdint>
namespace cg = cooperative_groups;
namespace pg8 {
#define PG8_LAS __attribute__((address_space(3)))
typedef unsigned short bf16_t;
typedef short bf16x8 __attribute__((ext_vector_type(8)));
typedef float f32x4 __attribute__((ext_vector_type(4)));
typedef unsigned u32x4 __attribute__((ext_vector_type(4)));
constexpr int BM = 256, BK = 64, HALF = 128, HTB = HALF * BK * 2  , STAGE_BYTES = 8 * HTB, NXCD = 8, WGM = 8;

__host__ __device__ __forceinline__ int lds_byte(int r, int c) { const int st = (r >> 4) * 2 + (c >> 5), rr = r & 15, cc = c & 31, ob = rr * 64 + cc * 2; return st * 1024 + (ob ^ (((ob >> 9) & 1) << 5)); }
__host__ __device__ __forceinline__ void stage_rc(int b, int& R, int& C) { const int st = b / 1024, sb = b % 1024, swz = sb ^ (((sb >> 9) & 1) << 5); R = (st >> 1) * 16 + swz / 64; C = (st & 1) * 32 + (swz % 64) / 2; }
__host__ __device__ __forceinline__ int perm32(int rho) { const int n = rho >> 4, i = rho & 15; return 8 * (i >> 2) + 4 * n + (i & 3); }

struct Unit { int pm, pn; };
struct Gemm { const bf16_t* A; const bf16_t* Bt; int M, N, K; };

struct StaticOrder {
    int nM, nN, nwg, G, c;
    __host__ __device__ void init(int M, int N, int G_, int c_) { nM = M / BM; nN = N / BM; nwg = nM * nN; G = G_; c = c_; }
    __host__ __device__ bool next(int i, Unit& u) const {
        const long L = (long)i * G + c; if (L >= nwg) return false;
        int wgid = (int)L; { const int q = nwg / NXCD, r = nwg % NXCD, xcd = wgid % NXCD, off = wgid / NXCD; wgid = (xcd < r ? xcd * (q + 1) : r * (q + 1) + (xcd - r) * q) + off; }
        const int nig = WGM * nN, gid = wgid / nig, fm = gid * WGM, gsz = (nM - fm) < WGM ? (nM - fm) : WGM;
        u.pm = fm + ((wgid % nig) % gsz); u.pn = (wgid % nig) / gsz; return true;
    }
    __device__ __forceinline__ void a_ready(const Unit&) const {}
    __device__ __forceinline__ void done(const Unit&) const {}
};
__device__ __forceinline__ unsigned cvt_pk_bf16(float lo, float hi) { unsigned r; asm volatile("v_cvt_pk_bf16_f32 %0, %1, %2" : "=v"(r) : "v"(lo), "v"(hi)); return r; }
typedef float f32x2 __attribute__((ext_vector_type(2)));
template <class Epi, class Sched, bool ALIGN_EPI = false, bool SP2 = false>
__device__ __forceinline__ void gemm_phase(PG8_LAS unsigned char* lds, const Gemm g, const Sched& S, const Epi& E) {
    const int tid = threadIdx.x, wid = __builtin_amdgcn_readfirstlane(tid >> 6), lane = tid & 63, wr = wid >> 2, wc = wid & 3, fr = lane & 15, fq = lane >> 4;
    const int K = g.K, nt = K / BK;
    unsigned voffA[2], voffB[2];
#pragma unroll
    for (int i = 0; i < 2; ++i) { int R, C; stage_rc(tid * 16 + i * 8192, R, C); const int Rb = Epi::PERM ? ((R & ~31) + perm32(R & 31)) : R;
        voffA[i] = (unsigned)(R * K + C) * 2u; voffB[i] = (unsigned)(Rb * K + C) * 2u; }
    const size_t kstep = (size_t)(BK * 2);
    const size_t hstep = (size_t)HALF * K * 2;
    const size_t tstep = 2 * hstep;
    const unsigned ldsw = (unsigned)wid * 1024u;
    const int aoff = lds_byte(wr * 64 + fr, fq * 8), boff = lds_byte(wc * 32 + fr, fq * 8);
#define PG8_SA(b, h) (((b) * 2 + (h)) * HTB)
#define PG8_SB(b, h) ((4 + (b) * 2 + (h)) * HTB)
#define PG8_STAGE(bufoff, gbase, voff) do { _Pragma("unroll") for (int _i = 0; _i < 2; ++_i) \
        __builtin_amdgcn_global_load_lds((const unsigned*)((const char*)(gbase) + (voff)[_i]), (PG8_LAS unsigned*)(lds + (bufoff) + ldsw + _i * 8192), 16, 0, 0); } while (0)
#define PG8_LDA(dst, b, h) do { _Pragma("unroll") for (int m = 0; m < 4; ++m) _Pragma("unroll") for (int k = 0; k < 2; ++k) dst[m][k] = *(const PG8_LAS bf16x8*)(lds + PG8_SA(b, h) + aoff + m * 2048 + k * 1024); } while (0)
#define PG8_LDB(dst, b, h) do { _Pragma("unroll") for (int n = 0; n < 2; ++n) _Pragma("unroll") for (int k = 0; k < 2; ++k) dst[n][k] = *(const PG8_LAS bf16x8*)(lds + PG8_SB(b, h) + boff + n * 2048 + k * 1024); } while (0)
#define PG8_MMA(ai, bj, At, Bt) do { __builtin_amdgcn_s_setprio(1); _Pragma("unroll") for (int m = 0; m < 4; ++m) _Pragma("unroll") for (int n = 0; n < 2; ++n) _Pragma("unroll") for (int k = 0; k < 2; ++k) \
        acc[ai][bj][m][n] = __builtin_amdgcn_mfma_f32_16x16x32_bf16(Bt[n][k], At[m][k], acc[ai][bj][m][n], 0, 0, 0); __builtin_amdgcn_s_setprio(0); } while (0)
#define PG8_WAIT_V(n) asm volatile("s_waitcnt vmcnt(" #n ")" ::: "memory")
#define PG8_WAIT_L(n) asm volatile("s_waitcnt lgkmcnt(" #n ")" ::: "memory")
#define PG8_BAR __builtin_amdgcn_s_barrier()
#define PG8_SCHED __builtin_amdgcn_sched_barrier(0)
    Unit cur, nxt; int ui = 0;
    if (!S.next(0, cur)) return;
    f32x4 acc[2][2][4][2];
#pragma unroll
    for (int a = 0; a < 2; ++a)
#pragma unroll
        for (int b = 0; b < 2; ++b)
#pragma unroll
            for (int m = 0; m < 4; ++m)
#pragma unroll
                for (int n = 0; n < 2; ++n) acc[a][b][m][n] = (f32x4){0.f, 0.f, 0.f, 0.f};
    bf16x8 At[4][2], B0[2][2], B1[2][2];
    const char* cA = (const char*)g.A + (size_t)cur.pm * tstep; const char* cB = (const char*)g.Bt + (size_t)cur.pn * tstep;
    S.a_ready(cur);
    if constexpr (SP2) {
        PG8_STAGE(PG8_SB(0, 0), cB, voffB); PG8_STAGE(PG8_SB(0, 1), cB + hstep, voffB); PG8_STAGE(PG8_SA(0, 0), cA, voffA); PG8_STAGE(PG8_SA(0, 1), cA + hstep, voffA);
        if (wr == 1) PG8_BAR;
        PG8_WAIT_V(2); PG8_BAR;
        PG8_STAGE(PG8_SB(1, 0), cB + kstep, voffB); PG8_STAGE(PG8_SA(1, 0), cA + kstep, voffA); PG8_STAGE(PG8_SB(1, 1), cB + hstep + kstep, voffB);
        PG8_WAIT_V(6); PG8_BAR;
    } else {
        PG8_STAGE(PG8_SB(0, 0), cB, voffB); PG8_STAGE(PG8_SA(0, 0), cA, voffA); PG8_STAGE(PG8_SB(0, 1), cB + hstep, voffB); PG8_STAGE(PG8_SA(0, 1), cA + hstep, voffA);
        if (wr == 1) PG8_BAR;
        PG8_WAIT_V(4); PG8_BAR;
        PG8_STAGE(PG8_SB(1, 0), cB + kstep, voffB); PG8_STAGE(PG8_SA(1, 0), cA + kstep, voffA); PG8_STAGE(PG8_SB(1, 1), cB + hstep + kstep, voffB);
        PG8_WAIT_V(6); PG8_BAR;
    }
    for (;;) {
        const bool has_next = S.next(ui + 1, nxt);
        const char* nA = has_next ? (const char*)g.A + (size_t)nxt.pm * tstep : cA; const char* nB = has_next ? (const char*)g.Bt + (size_t)nxt.pn * tstep : cB;
        for (int t = 0; t < nt; t += 2) {
            const bool last = (t == nt - 2);
            const char* a1 = cA + (size_t)(t + 1) * kstep;
            const char* a2 = last ? nA : cA + (size_t)(t + 2) * kstep; const char* b2 = last ? nB : cB + (size_t)(t + 2) * kstep;
            const char* a3 = a2 + kstep; const char* b3 = b2 + kstep;
            if (last && has_next) S.a_ready(nxt);
            if constexpr (SP2) {
            PG8_LDB(B0, 0, 0); PG8_LDB(B1, 0, 1); PG8_SCHED; PG8_LDA(At, 0, 0); PG8_STAGE(PG8_SA(1, 1), a1 + hstep, voffA);
            PG8_WAIT_V(8); PG8_WAIT_L(0); PG8_BAR; PG8_MMA(0, 0, At, B0); PG8_MMA(0, 1, At, B1); PG8_BAR; PG8_SCHED;
            PG8_LDA(At, 0, 1); PG8_STAGE(PG8_SB(0, 0), b2, voffB); PG8_STAGE(PG8_SB(0, 1), b2 + hstep, voffB); PG8_STAGE(PG8_SA(0, 0), a2, voffA);
            PG8_WAIT_V(8); PG8_WAIT_L(0); PG8_BAR; PG8_MMA(1, 0, At, B0); PG8_MMA(1, 1, At, B1); PG8_BAR; PG8_SCHED;
            PG8_LDB(B0, 1, 0); PG8_LDB(B1, 1, 1); PG8_SCHED; PG8_LDA(At, 1, 0); PG8_STAGE(PG8_SA(0, 1), a2 + hstep, voffA);
            PG8_WAIT_V(8); PG8_WAIT_L(0); PG8_BAR; PG8_MMA(0, 0, At, B0); PG8_MMA(0, 1, At, B1); PG8_BAR; PG8_SCHED;
            PG8_LDA(At, 1, 1); PG8_STAGE(PG8_SB(1, 0), b3, voffB); PG8_STAGE(PG8_SB(1, 1), b3 + hstep, voffB); PG8_STAGE(PG8_SA(1, 0), a3, voffA);
            PG8_WAIT_V(8); PG8_WAIT_L(0); PG8_BAR; PG8_MMA(1, 0, At, B0); PG8_MMA(1, 1, At, B1); PG8_BAR; PG8_SCHED;
            } else {
            PG8_LDB(B0, 0, 0); PG8_SCHED; PG8_LDA(At, 0, 0); PG8_STAGE(PG8_SA(1, 1), a1 + hstep, voffA);
            PG8_WAIT_L(8); PG8_BAR; PG8_WAIT_L(0); PG8_MMA(0, 0, At, B0); PG8_BAR; PG8_SCHED;
            PG8_LDB(B1, 0, 1); PG8_STAGE(PG8_SB(0, 0), b2, voffB);
            PG8_BAR; PG8_WAIT_L(0); PG8_MMA(0, 1, At, B1); PG8_BAR;
            PG8_LDA(At, 0, 1); PG8_STAGE(PG8_SA(0, 0), a2, voffA);
            PG8_BAR; PG8_WAIT_L(0); PG8_MMA(1, 0, At, B0); PG8_BAR; PG8_SCHED;
            PG8_STAGE(PG8_SB(0, 1), b2 + hstep, voffB);
            PG8_WAIT_V(6); PG8_BAR; PG8_MMA(1, 1, At, B1); PG8_BAR;
            PG8_LDB(B0, 1, 0); PG8_SCHED; PG8_LDA(At, 1, 0); PG8_STAGE(PG8_SA(0, 1), a2 + hstep, voffA);
            PG8_WAIT_L(8); PG8_BAR; PG8_WAIT_L(0); PG8_MMA(0, 0, At, B0); PG8_BAR; PG8_SCHED;
            PG8_LDB(B1, 1, 1); PG8_STAGE(PG8_SB(1, 0), b3, voffB);
            PG8_BAR; PG8_WAIT_L(0); PG8_MMA(0, 1, At, B1); PG8_BAR;
            PG8_LDA(At, 1, 1); PG8_STAGE(PG8_SA(1, 0), a3, voffA);
            PG8_BAR; PG8_WAIT_L(0); PG8_MMA(1, 0, At, B0); PG8_BAR; PG8_SCHED;
            PG8_STAGE(PG8_SB(1, 1), b3 + hstep, voffB);
            PG8_WAIT_V(6); PG8_BAR; PG8_MMA(1, 1, At, B1); PG8_BAR;
            }
        }
        if constexpr (ALIGN_EPI) { if (wr == 0) PG8_BAR; }
        if constexpr (!Epi::AFTER_DRAIN) { E(acc, cur, wr, wc, fr, fq); S.done(cur); }
        if (!has_next) break;
#pragma unroll
        for (int a = 0; a < 2; ++a)
#pragma unroll
            for (int b = 0; b < 2; ++b)
#pragma unroll
                for (int m = 0; m < 4; ++m)
#pragma unroll
                    for (int n = 0; n < 2; ++n) acc[a][b][m][n] = (f32x4){0.f, 0.f, 0.f, 0.f};
        cur = nxt; cA = nA; cB = nB; ++ui;
        if constexpr (ALIGN_EPI) { if (wr == 1) PG8_BAR; }
    }
    PG8_WAIT_V(0);
    if constexpr (!ALIGN_EPI) { if (wr == 0) PG8_BAR; }
    PG8_BAR;
    if constexpr (Epi::AFTER_DRAIN) { E.fused(acc, cur, wr, wc, fr, fq, lds, wid, lane); S.done(cur); }
#undef PG8_SA
#undef PG8_SB
#undef PG8_STAGE
#undef PG8_LDA
#undef PG8_LDB
#undef PG8_MMA
#undef PG8_WAIT_V
#undef PG8_WAIT_L
#undef PG8_BAR
#undef PG8_SCHED
}
}

constexpr int D = 1024, NP = 16384, NS = 1024, M = NP + NS, NIN = 4096, FF = 4096, TP = 2048;
constexpr float EPS = 1e-6f;
constexpr int NWAVES = 8, NTHR = 512;
#ifndef MK_N_LAUNCHES
#define MK_N_LAUNCHES 1
#endif
constexpr int N_PHASES = 7;
constexpr size_t MiB = 1u << 20;
constexpr size_t WS_WIN = 1 * MiB, WS_WOUT = 9 * MiB, WS_WUP = 11 * MiB, WS_WDN = 19 * MiB, WS_TAB = 27 * MiB, WS_SSQ = 29 * MiB;
constexpr size_t WS_XN = 32 * MiB;
constexpr size_t WS_PROJ = 66 * MiB;
constexpr size_t WS_OB = 202 * MiB;
constexpr size_t WS_END = 236 * MiB;
constexpr size_t OUT_Y = 0, OUT_RSP = (size_t)M * D, OUT_HSP = OUT_RSP + 8 * 4 * 16384, OUT_RSS = OUT_HSP + 8 * 4 * 16384, OUT_HSS = OUT_RSS + (size_t)128 * 4 * 16384;
constexpr int LDS_BYTES = 147456;

#define LAS __attribute__((address_space(3)))
typedef unsigned short bf16;
typedef unsigned v4u __attribute__((ext_vector_type(4)));
typedef unsigned v2u __attribute__((ext_vector_type(2)));
typedef float f32x4 __attribute__((ext_vector_type(4)));
#define LDS_WAIT() asm volatile("s_waitcnt lgkmcnt(0)" ::: "memory")

__device__ __forceinline__ unsigned f2bf(float f) { unsigned u = __builtin_bit_cast(unsigned, f); return (u + 0x7fffu + ((u >> 16) & 1u)) >> 16; }
__device__ __forceinline__ unsigned pk2(float lo, float hi) { return f2bf(lo) | (f2bf(hi) << 16); }
__device__ __forceinline__ float bflo(unsigned u) { return __uint_as_float(u << 16); }
__device__ __forceinline__ float bfhi(unsigned u) { return __uint_as_float(u & 0xffff0000u); }
__device__ __forceinline__ float sigmoidf_(float x) { return __builtin_amdgcn_rcpf(1.0f + __expf(-x)); }
__device__ __forceinline__ float siluf_(float x) { return x * sigmoidf_(x); }
__device__ __forceinline__ float wave_sum(float v) {
#pragma unroll
    for (int o = 1; o < 64; o <<= 1) v += __shfl_xor(v, o);
    return v;
}
__device__ __forceinline__ float log2gamma(int h) { return h == 0 ? -0.04580368961312479f : (h == 1 ? -0.02272007650008353f : (h == 2 ? -0.011315313227834146f : -0.005646563141142063f)); }

__constant__ double INVF[64] = {1.0, 0.8659643233600653, 0.7498942093324559, 0.6493816315762113, 0.5623413251903491, 0.4869675251658631, 0.4216965034285822, 0.3651741272548377, 0.31622776601683794, 0.27384196342643613, 0.23713737056616552, 0.2053525026457146, 0.1778279410038923, 0.1539926526059492, 0.1333521432163324, 0.11547819846894582, 0.1, 0.08659643233600653, 0.07498942093324558, 0.06493816315762113, 0.05623413251903491, 0.04869675251658631, 0.042169650342858224, 0.03651741272548377, 0.03162277660168379, 0.027384196342643614, 0.023713737056616554, 0.02053525026457146, 0.01778279410038923, 0.01539926526059492, 0.01333521432163324, 0.011547819846894581, 0.01, 0.008659643233600654, 0.007498942093324558, 0.006493816315762113, 0.005623413251903491, 0.004869675251658631, 0.004216965034285823, 0.003651741272548377, 0.0031622776601683794, 0.0027384196342643613, 0.0023713737056616554, 0.002053525026457146, 0.0017782794100389228, 0.001539926526059492, 0.001333521432163324, 0.0011547819846894581, 0.001, 0.0008659643233600654, 0.0007498942093324559, 0.0006493816315762113, 0.0005623413251903491, 0.0004869675251658631, 0.00042169650342858224, 0.0003651741272548377, 0.00031622776601683794, 0.0002738419634264361, 0.00023713737056616554, 0.0002053525026457146, 0.00017782794100389227, 0.0001539926526059492, 0.0001333521432163324, 0.00011547819846894582};

using pg8::Unit;

struct EpiProj {
    static constexpr bool PERM = true, AFTER_DRAIN = false;
    bf16* P; const float* tab; const float* lbl;
    __device__ __forceinline__ void operator()(const f32x4 (&acc)[2][2][4][2], const Unit& u, int wr, int wc, int fr, int fq) const {
        const int type = u.pn >> 1;
        const int row0 = u.pm * 256 + wr * 64 + fr, d0 = wc * 32 + 8 * fq, col0 = u.pn * 256 + d0;
        if (type <= 1) {
#pragma unroll
            for (int ai = 0; ai < 2; ++ai)
#pragma unroll
                for (int m = 0; m < 4; ++m) {
                    const int row = row0 + ai * 128 + m * 16;
                    const int pidx = row < NP ? (row & (TP - 1)) : TP + (row & 7);
                    const f32x4* tp = (const f32x4*)(tab + ((size_t)pidx * 64 + (d0 >> 1)) * 2);
                    const f32x4 cs0 = tp[0], cs1 = tp[1];
                    bf16* rowp = P + (size_t)row * NIN + col0;
#pragma unroll
                    for (int bj = 0; bj < 2; ++bj) {
                        float sc = 1.0f;
                        if (type == 1) { sc = 0.08838834764831845f; if (row < NP) sc *= exp2f(-(float)((row & 63) + 1) * log2gamma(2 * (u.pn & 1) + bj)); }
                        const f32x4 v0 = acc[ai][bj][m][0], v1 = acc[ai][bj][m][1];
                        v4u w;
                        w.x = pk2((v0[0] * cs0[0] - v0[1] * cs0[1]) * sc, (v0[0] * cs0[1] + v0[1] * cs0[0]) * sc);
                        w.y = pk2((v0[2] * cs0[2] - v0[3] * cs0[3]) * sc, (v0[2] * cs0[3] + v0[3] * cs0[2]) * sc);
                        w.z = pk2((v1[0] * cs1[0] - v1[1] * cs1[1]) * sc, (v1[0] * cs1[1] + v1[1] * cs1[0]) * sc);
                        w.w = pk2((v1[2] * cs1[2] - v1[3] * cs1[3]) * sc, (v1[2] * cs1[3] + v1[3] * cs1[2]) * sc);
                        *(v4u*)(rowp + bj * 128) = w;
                    }
                    if (m & 1) asm volatile("" ::: "memory");
                }
        } else if (type == 5) {
            float lb[2][8];
#pragma unroll
            for (int bj = 0; bj < 2; ++bj)
#pragma unroll
                for (int i = 0; i < 8; ++i) { const int c = (u.pn & 1) * 256 + bj * 128 + d0 + i; lb[bj][i] = sigmoidf_(lbl[c] - lbl[512 + c]); }
#pragma unroll
            for (int ai = 0; ai < 2; ++ai)
#pragma unroll
                for (int m = 0; m < 4; ++m) {
                    const int row = row0 + ai * 128 + m * 16;
                    bf16* rowp = P + (size_t)row * NIN + col0;
#pragma unroll
                    for (int bj = 0; bj < 2; ++bj) {
                        float o[8];
#pragma unroll
                        for (int i = 0; i < 8; ++i) { const float x = acc[ai][bj][m][i >> 2][i & 3]; const float f = lb[bj][i] + (1.0f - lb[bj][i]) * sigmoidf_(x); o[i] = __logf(f); }
                        v4u w; w.x = pk2(o[0], o[1]); w.y = pk2(o[2], o[3]); w.z = pk2(o[4], o[5]); w.w = pk2(o[6], o[7]);
                        *(v4u*)(rowp + bj * 128) = w;
                    }
                }
        } else {
            const bool act = (type == 3) || (type == 4) || (type == 7);
            const float sc = (type == 4) ? 0.08838834764831845f : 1.0f;
#pragma unroll
            for (int ai = 0; ai < 2; ++ai)
#pragma unroll
                for (int m = 0; m < 4; ++m) {
                    const int row = row0 + ai * 128 + m * 16;
                    bf16* rowp = P + (size_t)row * NIN + col0;
#pragma unroll
                    for (int bj = 0; bj < 2; ++bj) {
                        float o[8];
#pragma unroll
                        for (int i = 0; i < 8; ++i) { const float x = acc[ai][bj][m][i >> 2][i & 3]; o[i] = act ? siluf_(x) * sc : x; }
                        v4u w; w.x = pk2(o[0], o[1]); w.y = pk2(o[2], o[3]); w.z = pk2(o[4], o[5]); w.w = pk2(o[6], o[7]);
                        *(v4u*)(rowp + bj * 128) = w;
                    }
                }
        }
    }
};

struct EpiOut {
    static constexpr bool PERM = true, AFTER_DRAIN = false;
    const float* xp; const float* xs; float* X1; bf16* X1B; float* ssq;
    __device__ __forceinline__ void operator()(const f32x4 (&acc)[2][2][4][2], const Unit& u, int wr, int wc, int fr, int fq) const {
        const int row0 = u.pm * 256 + wr * 64 + fr, col0 = u.pn * 256 + wc * 32 + 8 * fq;
#pragma unroll
        for (int ai = 0; ai < 2; ++ai)
#pragma unroll
            for (int m = 0; m < 4; ++m) {
                const int row = row0 + ai * 128 + m * 16;
                const float* xr = (row < NP ? xp + (size_t)row * D : xs + (size_t)(row - NP) * D) + col0;
                float* op = X1 + (size_t)row * D + col0; bf16* bp = X1B + (size_t)row * D + col0;
                float s = 0.f;
#pragma unroll
                for (int bj = 0; bj < 2; ++bj) {
                    const f32x4 v0 = acc[ai][bj][m][0] + *(const f32x4*)(xr + bj * 128), v1 = acc[ai][bj][m][1] + *(const f32x4*)(xr + bj * 128 + 4);
                    *(f32x4*)(op + bj * 128) = v0; *(f32x4*)(op + bj * 128 + 4) = v1;
                    v4u w; w.x = pk2(v0[0], v0[1]); w.y = pk2(v0[2], v0[3]); w.z = pk2(v1[0], v1[1]); w.w = pk2(v1[2], v1[3]);
                    *(v4u*)(bp + bj * 128) = w;
                    s += (v0[0] * v0[0] + v0[1] * v0[1]) + (v0[2] * v0[2] + v0[3] * v0[3]) + (v1[0] * v1[0] + v1[1] * v1[1]) + (v1[2] * v1[2] + v1[3] * v1[3]);
                }
                s += __shfl_xor(s, 16); s += __shfl_xor(s, 32);
                if (fq == 0) ssq[(size_t)row * 16 + u.pn * 4 + wc] = s;
                if (m & 1) asm volatile("" ::: "memory");
            }
    }
};

struct EpiUp {
    static constexpr bool PERM = true, AFTER_DRAIN = false;
    bf16* H; const float* ssq;
    __device__ __forceinline__ void operator()(const f32x4 (&acc)[2][2][4][2], const Unit& u, int wr, int wc, int fr, int fq) const {
        const int row0 = u.pm * 256 + wr * 64 + fr, col0 = u.pn * 256 + wc * 32 + 8 * fq;
#pragma unroll
        for (int ai = 0; ai < 2; ++ai)
#pragma unroll
            for (int m = 0; m < 4; ++m) {
                const int row = row0 + ai * 128 + m * 16;
                const f32x4* sp = (const f32x4*)(ssq + (size_t)row * 16);
                const f32x4 a = sp[0], b = sp[1], c = sp[2], d = sp[3];
                const float ss = ((a[0] + a[1]) + (a[2] + a[3])) + ((b[0] + b[1]) + (b[2] + b[3])) + ((c[0] + c[1]) + (c[2] + c[3])) + ((d[0] + d[1]) + (d[2] + d[3]));
                const float r2 = 1.0f / (ss * (1.0f / D) + EPS);
                bf16* hp = H + (size_t)row * FF + col0;
#pragma unroll
                for (int bj = 0; bj < 2; ++bj) {
                    float o[8];
#pragma unroll
                    for (int i = 0; i < 8; ++i) { const float x = fmaxf(acc[ai][bj][m][i >> 2][i & 3], 0.f); o[i] = x * x * r2; }
                    v4u w; w.x = pk2(o[0], o[1]); w.y = pk2(o[2], o[3]); w.z = pk2(o[4], o[5]); w.w = pk2(o[6], o[7]);
                    *(v4u*)(hp + bj * 128) = w;
                }
                if (m & 1) asm volatile("" ::: "memory");
            }
    }
};

struct EpiDown {
    static constexpr bool PERM = true, AFTER_DRAIN = false;
    float* X;
    __device__ __forceinline__ void operator()(const f32x4 (&acc)[2][2][4][2], const Unit& u, int wr, int wc, int fr, int fq) const {
        const int row0 = u.pm * 256 + wr * 64 + fr, col0 = u.pn * 256 + wc * 32 + 8 * fq;
#pragma unroll
        for (int ai = 0; ai < 2; ++ai)
#pragma unroll
            for (int m = 0; m < 4; ++m) {
                float* op = X + (size_t)(row0 + ai * 128 + m * 16) * D + col0;
#pragma unroll
                for (int bj = 0; bj < 2; ++bj) {
                    const f32x4 v0 = acc[ai][bj][m][0] + *(const f32x4*)(op + bj * 128), v1 = acc[ai][bj][m][1] + *(const f32x4*)(op + bj * 128 + 4);
                    *(f32x4*)(op + bj * 128) = v0; *(f32x4*)(op + bj * 128 + 4) = v1;
                }
                if (m & 1) asm volatile("" ::: "memory");
            }
    }
};

__device__ __forceinline__ int wmap_in(int n) { if (n < 1024) { const int d = n & 127; return (n & ~127) | ((d & 63) << 1) | (d >> 6); } return n; }
template <bool MAP>
__device__ __forceinline__ void p0_transpose_item(const float* W, int K, int N, bf16* WT, const float* kscale, LAS float* scr, int item, int lane) {
    const int nblk = N / 32, kb = item / nblk, nb = item % nblk, k0 = 64 * kb, n0 = 32 * nb;
#pragma unroll 8
    for (int i = 0; i < 32; ++i) { const int kk = 2 * i + (lane >> 5); float w = W[(size_t)(k0 + kk) * N + n0 + (lane & 31)]; if (kscale) w *= kscale[k0 + kk]; scr[kk * 33 + (lane & 31)] = w; }
    LDS_WAIT(); asm volatile("" ::: "memory");
    const int c = lane & 7;
#pragma unroll
    for (int j = 0; j < 4; ++j) { const int n = (lane >> 3) + 8 * j; const LAS float* s = scr + (8 * c) * 33 + n;
        v4u o; o.x = pk2(s[0 * 33], s[1 * 33]); o.y = pk2(s[2 * 33], s[3 * 33]); o.z = pk2(s[4 * 33], s[5 * 33]); o.w = pk2(s[6 * 33], s[7 * 33]);
        const int nd = MAP ? wmap_in(n0 + n) : (n0 + n);
        *(v4u*)(WT + (size_t)nd * K + k0 + 8 * c) = o; }
    LDS_WAIT(); asm volatile("" ::: "memory");
}
__device__ __forceinline__ void rms_row_to_bf16(const float* xrow, const float* w, bf16* orow, int lane) {
    const f32x4* xr = (const f32x4*)xrow + lane; const f32x4* wr_ = (const f32x4*)w + lane;
    f32x4 v[4]; float s = 0.f;
#pragma unroll
    for (int j = 0; j < 4; ++j) { v[j] = xr[64 * j]; s += (v[j][0] * v[j][0] + v[j][1] * v[j][1]) + (v[j][2] * v[j][2] + v[j][3] * v[j][3]); }
    const float rstd = rsqrtf(wave_sum(s) * (1.f / D) + EPS);
    unsigned long long* o8 = (unsigned long long*)orow + lane;
#pragma unroll
    for (int j = 0; j < 4; ++j) { const f32x4 ww = wr_[64 * j]; const f32x4 o = v[j] * rstd * ww; o8[64 * j] = (unsigned long long)pk2(o[0], o[1]) | ((unsigned long long)pk2(o[2], o[3]) << 32); }
}
__device__ __forceinline__ void rms_row_inplace(float* xrow, const float* w, int lane) {
    f32x4* xr = (f32x4*)xrow + lane; const f32x4* wr_ = (const f32x4*)w + lane;
    f32x4 v[4]; float s = 0.f;
#pragma unroll
    for (int j = 0; j < 4; ++j) { v[j] = xr[64 * j]; s += (v[j][0] * v[j][0] + v[j][1] * v[j][1]) + (v[j][2] * v[j][2] + v[j][3] * v[j][3]); }
    const float rstd = rsqrtf(wave_sum(s) * (1.f / D) + EPS);
#pragma unroll
    for (int j = 0; j < 4; ++j) xr[64 * j] = v[j] * rstd * wr_[64 * j];
}

template <bool HG>
__device__ __forceinline__ void rec_unit(LAS unsigned char* lds, const bf16* proj, bf16* OB, const float* normw, size_t row0, int T, int h, bool prompt, const float* s_in, float* s_out, int tid) {
    const int w = __builtin_amdgcn_readfirstlane(tid >> 6), lane = tid & 63, dq = lane >> 2, vq = lane & 3;
    const int colq = (HG ? 2048 : 0) + 128 * h, colk = colq + 512, colv = colq + 1024, colg = colq + 1536, colo = (HG ? 512 : 0) + 128 * h;
    LAS bf16* Qs = (LAS bf16*)lds; LAS bf16* Ks = Qs + 64 * 128; LAS bf16* Vs = Ks + 64 * 128; LAS float* Os = (LAS float*)(lds + 49152);
    float S[8][4];
    const int vcol = 16 * w + 4 * vq;
#pragma unroll
    for (int i = 0; i < 8; ++i) { const int p = 8 * dq + i, d = HG ? p : ((p >> 1) + 64 * (p & 1));
        if (s_in) { const f32x4 t = *(const f32x4*)(s_in + (size_t)d * 128 + vcol); S[i][0] = t[0]; S[i][1] = t[1]; S[i][2] = t[2]; S[i][3] = t[3]; }
        else { S[i][0] = 0.f; S[i][1] = 0.f; S[i][2] = 0.f; S[i][3] = 0.f; } }
    const float l2g = log2gamma(h), gam = exp2f(l2g);
    for (int t0 = 0; t0 < T; t0 += 64) {
        const int TC = (T - t0) < 64 ? (T - t0) : 64;
        __syncthreads();
        for (int i = tid; i < TC * 16; i += NTHR) { const int r = i >> 4, c = i & 15; const bf16* src = proj + (row0 + t0 + r) * NIN + c * 8;
            *(LAS v4u*)(Qs + r * 128 + c * 8) = *(const v4u*)(src + colq); *(LAS v4u*)(Ks + r * 128 + c * 8) = *(const v4u*)(src + colk); *(LAS v4u*)(Vs + r * 128 + c * 8) = *(const v4u*)(src + colv); }
        __syncthreads();
        for (int t = 0; t < TC; ++t) {
            const v4u qu = *(const LAS v4u*)(Qs + t * 128 + 8 * dq), ku = *(const LAS v4u*)(Ks + t * 128 + 8 * dq); const v2u vu = *(const LAS v2u*)(Vs + t * 128 + vcol);
            float q[8], k[8], f[8], v[4];
            q[0] = bflo(qu.x); q[1] = bfhi(qu.x); q[2] = bflo(qu.y); q[3] = bfhi(qu.y); q[4] = bflo(qu.z); q[5] = bfhi(qu.z); q[6] = bflo(qu.w); q[7] = bfhi(qu.w);
            k[0] = bflo(ku.x); k[1] = bfhi(ku.x); k[2] = bflo(ku.y); k[3] = bfhi(ku.y); k[4] = bflo(ku.z); k[5] = bfhi(ku.z); k[6] = bflo(ku.w); k[7] = bfhi(ku.w);
            v[0] = bflo(vu.x); v[1] = bfhi(vu.x); v[2] = bflo(vu.y); v[3] = bfhi(vu.y);
            if (HG) {
#pragma unroll
                for (int i = 0; i < 8; ++i) { f[i] = __expf(k[i]); k[i] = 1.0f - f[i]; }
            } else {
                const float ks = prompt ? exp2f((float)(((t0 + t) & 63) + 1) * l2g) : 1.0f;
#pragma unroll
                for (int i = 0; i < 8; ++i) { f[i] = gam; k[i] *= ks; }
            }
            float o[4] = {0.f, 0.f, 0.f, 0.f};
#pragma unroll
            for (int i = 0; i < 8; ++i)
#pragma unroll
                for (int c = 0; c < 4; ++c) { S[i][c] = f[i] * S[i][c] + k[i] * v[c]; o[c] += q[i] * S[i][c]; }
#pragma unroll
            for (int c = 0; c < 4; ++c) { o[c] += __shfl_xor(o[c], 4); o[c] += __shfl_xor(o[c], 8); o[c] += __shfl_xor(o[c], 16); o[c] += __shfl_xor(o[c], 32); }
            if (dq == 0) *(LAS f32x4*)(Os + t * 128 + vcol) = (f32x4){o[0], o[1], o[2], o[3]};
        }
        __syncthreads();
        {
            const int r = tid >> 3, seg = tid & 7;
            if (r < TC) {
                float x[16]; float s = 0.f;
#pragma unroll
                for (int i = 0; i < 4; ++i) { const f32x4 t = *(const LAS f32x4*)(Os + r * 128 + seg * 16 + 4 * i); x[4 * i] = t[0]; x[4 * i + 1] = t[1]; x[4 * i + 2] = t[2]; x[4 * i + 3] = t[3]; s += (t[0] * t[0] + t[1] * t[1]) + (t[2] * t[2] + t[3] * t[3]); }
                s += __shfl_xor(s, 1); s += __shfl_xor(s, 2); s += __shfl_xor(s, 4);
                const float rstd = rsqrtf(s * (1.0f / 128.0f) + EPS);
                const bf16* gp = proj + (row0 + t0 + r) * NIN + colg + seg * 16;
                const v4u g0 = *(const v4u*)gp, g1 = *(const v4u*)(gp + 8);
                const unsigned gu[8] = {g0.x, g0.y, g0.z, g0.w, g1.x, g1.y, g1.z, g1.w};
                unsigned ou[8];
#pragma unroll
                for (int i = 0; i < 8; ++i) { const float a = x[2 * i] * rstd * normw[seg * 16 + 2 * i] * bflo(gu[i]), b = x[2 * i + 1] * rstd * normw[seg * 16 + 2 * i + 1] * bfhi(gu[i]); ou[i] = pk2(a, b); }
                bf16* op = OB + (row0 + t0 + r) * D + colo + seg * 16;
                *(v4u*)op = (v4u){ou[0], ou[1], ou[2], ou[3]}; *(v4u*)(op + 8) = (v4u){ou[4], ou[5], ou[6], ou[7]};
            }
        }
    }
#pragma unroll
    for (int i = 0; i < 8; ++i) { const int p = 8 * dq + i, d = HG ? p : ((p >> 1) + 64 * (p & 1)); *(f32x4*)(s_out + (size_t)d * 128 + vcol) = (f32x4){S[i][0], S[i][1], S[i][2], S[i][3]}; }
}


typedef short bf16x8 __attribute__((ext_vector_type(8)));
constexpr int QS_STRIDE = 144, TS_STRIDE = 80, OS_STRIDE = 132;
constexpr int L_QS = 0, L_KS = 18432, L_KT = 36864, L_VT = 57344, L_PS = 77824, L_OS = 88064, L_ES = 121856, L_FS = 122368;
#define MFMA16(a, b, c) __builtin_amdgcn_mfma_f32_16x16x32_bf16((a), (b), (c), 0, 0, 0)
template <bool HG>
__device__ __forceinline__ void chunk_unit(LAS unsigned char* lds, const bf16* proj, bf16* OB, const float* normw, size_t row0, int nchunks, int h, float* s_out, int tid) {
    const int w = __builtin_amdgcn_readfirstlane(tid >> 6), lane = tid & 63, n = lane & 15, g = lane >> 4;
    const int colq = (HG ? 2048 : 0) + 128 * h, colk = colq + 512, colv = colq + 1024, colg = colq + 1536, colo = (HG ? 512 : 0) + 128 * h;
    LAS bf16* Qs = (LAS bf16*)(lds + L_QS); LAS bf16* Ks = (LAS bf16*)(lds + L_KS); LAS bf16* Kt = (LAS bf16*)(lds + L_KT); LAS bf16* Vt = (LAS bf16*)(lds + L_VT);
    LAS bf16* Ps = (LAS bf16*)(lds + L_PS); LAS float* Os = (LAS float*)(lds + L_OS); LAS float* Es = (LAS float*)(lds + L_ES); LAS float* Fs = (LAS float*)(lds + L_FS);
    const float l2g = log2gamma(h);
    f32x4 S[8];
#pragma unroll
    for (int j = 0; j < 8; ++j) S[j] = (f32x4){0.f, 0.f, 0.f, 0.f};
    v4u rq[2], rk[2], rv[2], rg[2];
    {   const bf16* src = proj + (row0 + lane) * NIN;
#pragma unroll
        for (int pc = 0; pc < 2; ++pc) { const int cc = w + 8 * pc; rq[pc] = *(const v4u*)(src + colq + 8 * cc); rk[pc] = *(const v4u*)(src + colk + 8 * cc); rv[pc] = *(const v4u*)(src + colv + 8 * cc); } }
    const int er = tid >> 3, eseg = tid & 7;
    for (int c = 0; c < nchunks; ++c) {
        const size_t crow = row0 + (size_t)c * 64;
#pragma unroll
        for (int pc = 0; pc < 2; ++pc) {
            const int cc = w + 8 * pc;
            v4u qo, ko;
            if (!HG) { qo = rq[pc]; ko = rk[pc]; }
            else {
                const unsigned qu[4] = {rq[pc].x, rq[pc].y, rq[pc].z, rq[pc].w}, gu[4] = {rk[pc].x, rk[pc].y, rk[pc].z, rk[pc].w};
                float q[8], gg[8], b[8];
#pragma unroll
                for (int i = 0; i < 4; ++i) { q[2 * i] = bflo(qu[i]); q[2 * i + 1] = bfhi(qu[i]); gg[2 * i] = bflo(gu[i]); gg[2 * i + 1] = bfhi(gu[i]); }
#pragma unroll
                for (int i = 0; i < 8; ++i) b[i] = gg[i];
#pragma unroll
                for (int off = 1; off < 64; off <<= 1) {
#pragma unroll
                    for (int i = 0; i < 8; ++i) { const float t = __shfl_up(b[i], off); if (lane >= off) b[i] += t; }
                }
                float qp[8], kp[8];
#pragma unroll
                for (int i = 0; i < 8; ++i) {
                    const float b32 = __shfl(b[i], 31), b63 = __shfl(b[i], 63);
                    const float f = __expf(gg[i]);
                    float dlt = b[i] - b32; dlt = fminf(fmaxf(dlt, -80.f), 80.f);
                    qp[i] = q[i] * __expf(dlt); kp[i] = (1.0f - f) * __expf(-dlt);
                    if (lane == 31) Es[8 * cc + i] = __expf(b32);
                    if (lane == 63) Fs[8 * cc + i] = __expf(b63 - b32);
                }
                qo = (v4u){pk2(qp[0], qp[1]), pk2(qp[2], qp[3]), pk2(qp[4], qp[5]), pk2(qp[6], qp[7])};
                ko = (v4u){pk2(kp[0], kp[1]), pk2(kp[2], kp[3]), pk2(kp[4], kp[5]), pk2(kp[6], kp[7])};
            }
            *(LAS v4u*)(Qs + lane * QS_STRIDE + 8 * cc) = qo;
            *(LAS v4u*)(Ks + lane * QS_STRIDE + 8 * cc) = ko;
            const unsigned ku[4] = {ko.x, ko.y, ko.z, ko.w}, vu[4] = {rv[pc].x, rv[pc].y, rv[pc].z, rv[pc].w};
#pragma unroll
            for (int i = 0; i < 8; ++i) { Kt[(8 * cc + i) * TS_STRIDE + lane] = (bf16)(ku[i >> 1] >> (16 * (i & 1))); Vt[(8 * cc + i) * TS_STRIDE + lane] = (bf16)(vu[i >> 1] >> (16 * (i & 1))); }
        }
        __syncthreads();
        if (c + 1 < nchunks) { const bf16* src = proj + (crow + 64 + lane) * NIN;
#pragma unroll
            for (int pc = 0; pc < 2; ++pc) { const int cc = w + 8 * pc; rq[pc] = *(const v4u*)(src + colq + 8 * cc); rk[pc] = *(const v4u*)(src + colk + 8 * cc); rv[pc] = *(const v4u*)(src + colv + 8 * cc); } }
        { const bf16* gp = proj + (crow + er) * NIN + colg + eseg * 16; rg[0] = *(const v4u*)gp; rg[1] = *(const v4u*)(gp + 8); }
        {   const int I = w >> 1;
#pragma unroll
            for (int jj = 0; jj < 2; ++jj) {
                const int J = 2 * (w & 1) + jj;
                f32x4 a4 = (f32x4){0.f, 0.f, 0.f, 0.f};
                if (J <= I) {
#pragma unroll
                    for (int kk = 0; kk < 4; ++kk) {
                        const bf16x8 ka = *(const LAS bf16x8*)(Ks + (16 * J + n) * QS_STRIDE + 32 * kk + 8 * g);
                        const bf16x8 qb = *(const LAS bf16x8*)(Qs + (16 * I + n) * QS_STRIDE + 32 * kk + 8 * g);
                        a4 = MFMA16(ka, qb, a4);
                    }
                    if (J == I) {
#pragma unroll
                        for (int i = 0; i < 4; ++i) if (4 * g + i > n) a4[i] = 0.f;
                    }
                }
                *(LAS v2u*)(Ps + (16 * I + n) * TS_STRIDE + 16 * J + 4 * g) = (v2u){pk2(a4[0], a4[1]), pk2(a4[2], a4[3])};
            }
        }
        f32x4 O[4];
#pragma unroll
        for (int I = 0; I < 4; ++I) O[I] = (f32x4){0.f, 0.f, 0.f, 0.f};
        {
            if (HG) {
#pragma unroll
                for (int j = 0; j < 8; ++j) S[j] *= *(const LAS f32x4*)(Es + 16 * j + 4 * g);
            }
            bf16x8 sb[4];
#pragma unroll
            for (int kk = 0; kk < 4; ++kk) sb[kk] = __builtin_bit_cast(bf16x8, (v4u){pk2(S[2 * kk][0], S[2 * kk][1]), pk2(S[2 * kk][2], S[2 * kk][3]), pk2(S[2 * kk + 1][0], S[2 * kk + 1][1]), pk2(S[2 * kk + 1][2], S[2 * kk + 1][3])});
#pragma unroll
            for (int I = 0; I < 4; ++I)
#pragma unroll
                for (int kk = 0; kk < 4; ++kk) {
                    const v2u lo = *(const LAS v2u*)(Qs + (16 * I + n) * QS_STRIDE + 32 * kk + 4 * g), hi = *(const LAS v2u*)(Qs + (16 * I + n) * QS_STRIDE + 32 * kk + 16 + 4 * g);
                    O[I] = MFMA16(__builtin_bit_cast(bf16x8, (v4u){lo.x, lo.y, hi.x, hi.y}), sb[kk], O[I]);
                }
        }
        __syncthreads();
        {
            bf16x8 vb[2];
#pragma unroll
            for (int kk = 0; kk < 2; ++kk) vb[kk] = *(const LAS bf16x8*)(Vt + (16 * w + n) * TS_STRIDE + 32 * kk + 8 * g);
#pragma unroll
            for (int I = 0; I < 4; ++I)
#pragma unroll
                for (int kk = 0; kk < 2; ++kk) O[I] = MFMA16(*(const LAS bf16x8*)(Ps + (16 * I + n) * TS_STRIDE + 32 * kk + 8 * g), vb[kk], O[I]);
#pragma unroll
            for (int j = 0; j < 8; ++j)
#pragma unroll
                for (int kk = 0; kk < 2; ++kk) S[j] = MFMA16(*(const LAS bf16x8*)(Kt + (16 * j + n) * TS_STRIDE + 32 * kk + 8 * g), vb[kk], S[j]);
            if (HG) {
#pragma unroll
                for (int j = 0; j < 8; ++j) S[j] *= *(const LAS f32x4*)(Fs + 16 * j + 4 * g);
            } else {
                const float f64 = exp2f(64.0f * l2g);
#pragma unroll
                for (int j = 0; j < 8; ++j) S[j] *= f64;
            }
        }
#pragma unroll
        for (int I = 0; I < 4; ++I)
#pragma unroll
            for (int i = 0; i < 4; ++i) { const int t = 16 * I + 4 * g + i; const float rs = HG ? 1.0f : exp2f((float)(t + 1) * l2g); Os[t * OS_STRIDE + 16 * w + n] = O[I][i] * rs; }
        __syncthreads();
        {
            float x[16]; float s = 0.f;
#pragma unroll
            for (int i = 0; i < 4; ++i) { const f32x4 t = *(const LAS f32x4*)(Os + er * OS_STRIDE + eseg * 16 + 4 * i); x[4 * i] = t[0]; x[4 * i + 1] = t[1]; x[4 * i + 2] = t[2]; x[4 * i + 3] = t[3]; s += (t[0] * t[0] + t[1] * t[1]) + (t[2] * t[2] + t[3] * t[3]); }
            s += __shfl_xor(s, 1); s += __shfl_xor(s, 2); s += __shfl_xor(s, 4);
            const float rstd = rsqrtf(s * (1.0f / 128.0f) + EPS);
            const unsigned gu[8] = {rg[0].x, rg[0].y, rg[0].z, rg[0].w, rg[1].x, rg[1].y, rg[1].z, rg[1].w};
            unsigned ou[8];
#pragma unroll
            for (int i = 0; i < 8; ++i) { const float a = x[2 * i] * rstd * normw[eseg * 16 + 2 * i] * bflo(gu[i]), b = x[2 * i + 1] * rstd * normw[eseg * 16 + 2 * i + 1] * bfhi(gu[i]); ou[i] = pk2(a, b); }
            bf16* op = OB + (crow + er) * D + colo + eseg * 16;
            *(v4u*)op = (v4u){ou[0], ou[1], ou[2], ou[3]}; *(v4u*)(op + 8) = (v4u){ou[4], ou[5], ou[6], ou[7]};
        }
    }
#pragma unroll
    for (int j = 0; j < 8; ++j)
#pragma unroll
        for (int i = 0; i < 4; ++i) { const int p = 16 * j + 4 * g + i, d = HG ? p : ((p >> 1) + 64 * (p & 1)); s_out[(size_t)d * 128 + 16 * w + n] = S[j][i]; }
    __syncthreads();
}

struct Args { const float* in[14]; float* out; unsigned char* ws; int ph_lo, ph_hi; };
__global__ void __launch_bounds__(NTHR, 2) mega_fwd(Args a) {
    extern __shared__ __attribute__((aligned(16))) unsigned char lds_raw[];
    LAS unsigned char* lds = (LAS unsigned char*)lds_raw;
    cg::grid_group grid = cg::this_grid();
    const int tid = threadIdx.x, lane = tid & 63, wave = __builtin_amdgcn_readfirstlane(tid >> 6);
    const int G = gridDim.x, bx = blockIdx.x;
    const float* x_p = a.in[0]; const float* x_s = a.in[1]; const float* st_ret = a.in[2]; const float* st_hg = a.in[3];
    const float* norm_mix_w = a.in[4]; const float* w_in = a.in[5]; const float* ret_norm_w = a.in[6]; const float* hg_norm_w = a.in[7];
    const float* lb_logits = a.in[8]; const float* w_out = a.in[9]; const float* norm_ffn_w = a.in[10]; const float* w_up = a.in[11]; const float* w_down = a.in[12];
    const float* final_norm_w = a.in[13];
    unsigned char* ws = a.ws; float* out = a.out;
    bf16* WinT = (bf16*)(ws + WS_WIN); bf16* WoutT = (bf16*)(ws + WS_WOUT); bf16* WupT = (bf16*)(ws + WS_WUP); bf16* WdnT = (bf16*)(ws + WS_WDN);
    float* tab = (float*)(ws + WS_TAB); float* ssq = (float*)(ws + WS_SSQ);
    bf16* XN = (bf16*)(ws + WS_XN); bf16* PROJ = (bf16*)(ws + WS_PROJ); bf16* HB = (bf16*)(ws + WS_PROJ); bf16* OB = (bf16*)(ws + WS_OB);
    const int lo = a.ph_lo, hi = a.ph_hi;
#define IN(k) (lo <= (k) && (k) < hi)
#define SEAM(k) do { if (IN(k) && IN((k) + 1)) grid.sync(); } while (0)

    if (IN(0)) {
        LAS float* scr = (LAS float*)(lds + wave * 16384);
        const int gw = bx * NWAVES + wave, NGW = G * NWAVES;
        constexpr int I_IN = (D / 64) * (NIN / 32), I_OUT = (D / 64) * (D / 32), I_UP = (D / 64) * (FF / 32), I_DN = (FF / 64) * (D / 32);
        for (int it = gw; it < I_IN + I_OUT + I_UP + I_DN; it += NGW) {
            int r = it;
            if (r < I_IN) { p0_transpose_item<true>(w_in, D, NIN, WinT, nullptr, scr, r, lane); continue; } r -= I_IN;
            if (r < I_OUT) { p0_transpose_item<false>(w_out, D, D, WoutT, nullptr, scr, r, lane); continue; } r -= I_OUT;
            if (r < I_UP) { p0_transpose_item<false>(w_up, D, FF, WupT, norm_ffn_w, scr, r, lane); continue; } r -= I_UP;
            p0_transpose_item<false>(w_down, FF, D, WdnT, nullptr, scr, r, lane);
        }
        for (int m = gw; m < M; m += NGW) rms_row_to_bf16(m < NP ? x_p + (size_t)m * D : x_s + (size_t)(m - NP) * D, norm_mix_w, XN + (size_t)m * D, lane);
        for (int i = bx * NTHR + tid; i < (TP + 8) * 64; i += G * NTHR) {
            const int pi = i >> 6, j = i & 63; const double pos = (double)(pi < TP ? pi : 16384 + (pi - TP));
            double t = pos * INVF[j] * 0.15915494309189535; t -= __builtin_rint(t);
            tab[2 * i] = __builtin_amdgcn_cosf((float)t); tab[2 * i + 1] = __builtin_amdgcn_sinf((float)t);
        }
    }
    SEAM(0);
    if (IN(1)) {
        pg8::Gemm g{XN, WinT, M, NIN, D}; pg8::StaticOrder S; S.init(M, NIN, G, bx);
        EpiProj E{PROJ, tab, lb_logits};
        pg8::gemm_phase<EpiProj, pg8::StaticOrder, true, true>(lds, g, S, E);
    }
    SEAM(1);
    if (IN(2)) {
        if (bx < 64) {
            const int b = bx >> 3, hd = bx & 7; const size_t row0 = (size_t)b * TP;
            if (hd < 4) chunk_unit<false>(lds, PROJ, OB, ret_norm_w, row0, TP / 64, hd, out + OUT_RSP + (size_t)(b * 4 + hd) * 16384, tid);
            else chunk_unit<true>(lds, PROJ, OB, hg_norm_w, row0, TP / 64, hd - 4, out + OUT_HSP + (size_t)(b * 4 + hd - 4) * 16384, tid);
        } else {
            for (int u = bx - 64; u < 1024; u += G - 64) {
                const int b = u >> 3, hd = u & 7; const size_t row0 = (size_t)NP + (size_t)b * 8;
                if (hd < 4) rec_unit<false>(lds, PROJ, OB, ret_norm_w, row0, 8, hd, false, st_ret + (size_t)(b * 4 + hd) * 16384, out + OUT_RSS + (size_t)(b * 4 + hd) * 16384, tid);
                else rec_unit<true>(lds, PROJ, OB, hg_norm_w, row0, 8, hd - 4, false, st_hg + (size_t)(b * 4 + hd - 4) * 16384, out + OUT_HSS + (size_t)(b * 4 + hd - 4) * 16384, tid);
            }
        }
    }
    SEAM(2);
    if (IN(3)) {
        pg8::Gemm g{OB, WoutT, M, D, D}; pg8::StaticOrder S; S.init(M, D, G, bx);
        EpiOut E{x_p, x_s, out + OUT_Y, XN, ssq};
        pg8::gemm_phase<EpiOut, pg8::StaticOrder, true, true>(lds, g, S, E);
    }
    SEAM(3);
    if (IN(4)) {
        pg8::Gemm g{XN, WupT, M, FF, D}; pg8::StaticOrder S; S.init(M, FF, G, bx);
        EpiUp E{HB, ssq};
        pg8::gemm_phase<EpiUp, pg8::StaticOrder, true, true>(lds, g, S, E);
    }
    SEAM(4);
    if (IN(5)) {
        pg8::Gemm g{HB, WdnT, M, D, FF}; pg8::StaticOrder S; S.init(M, D, G, bx);
        EpiDown E{out + OUT_Y};
        pg8::gemm_phase<EpiDown, pg8::StaticOrder, true, true>(lds, g, S, E);
    }
    SEAM(5);
    if (IN(6)) {
        const int gw = bx * NWAVES + wave, NGW = G * NWAVES;
        for (int m = gw; m < M; m += NGW) rms_row_inplace(out + OUT_Y + (size_t)m * D, final_norm_w, lane);
    }
#undef IN
#undef SEAM
}

extern "C" void kernel_launch(void* const* d_in, const int* in_sizes, int n_in, void* d_out, int out_size, void* d_ws, size_t ws_size, hipStream_t stream) {
    static int grid = 0;
    if (grid == 0) {
        if (n_in != 14 || in_sizes[0] != NP * D || ws_size < WS_END) { fprintf(stderr, "kernel_launch: unexpected shapes (n_in %d, in0 %d, ws %zu)\n", n_in, n_in > 0 ? in_sizes[0] : -1, ws_size); grid = -1; return; }
        int dev = 0, cus = 0, per_cu = 0;
        if (hipGetDevice(&dev) != hipSuccess || hipDeviceGetAttribute(&cus, hipDeviceAttributeMultiprocessorCount, dev) != hipSuccess) { grid = -1; return; }
        if (hipFuncSetAttribute((const void*)mega_fwd, hipFuncAttributeMaxDynamicSharedMemorySize, LDS_BYTES) != hipSuccess) { fprintf(stderr, "kernel_launch: hipFuncSetAttribute failed\n"); grid = -1; return; }
        if (hipOccupancyMaxActiveBlocksPerMultiprocessor(&per_cu, (const void*)mega_fwd, NTHR, LDS_BYTES) != hipSuccess || per_cu < 1) { fprintf(stderr, "kernel_launch: occupancy query says %d blocks per CU\n", per_cu); (void)hipGetLastError(); grid = -1; return; }
        grid = cus;
        if (grid < 128) { fprintf(stderr, "kernel_launch: needs >= 128 CUs\n"); grid = -1; return; }
    }
    if (grid < 0) return;
    Args a{};
    for (int i = 0; i < 14; ++i) a.in[i] = (const float*)d_in[i];
    a.out = (float*)d_out; a.ws = (unsigned char*)d_ws;
#if MK_N_LAUNCHES == 1
    a.ph_lo = 0; a.ph_hi = N_PHASES;
    void* args[] = {&a};
    hipError_t e = hipLaunchCooperativeKernel((const void*)mega_fwd, dim3(grid), dim3(NTHR), args, LDS_BYTES, stream);
    if (e != hipSuccess) fprintf(stderr, "cooperative launch failed: %s (grid %d)\n", hipGetErrorString(e), grid);
#else
    for (int p = 0; p < N_PHASES; ++p) { a.ph_lo = p; a.ph_hi = p + 1; hipLaunchKernelGGL(mega_fwd, dim3(grid), dim3(NTHR), LDS_BYTES, stream, a); }
#endif
}
```

```cpp
#include <hip/hip_runtime.h>
#include <hip/hip_cooperative_groups.h>
#include <cstdio>
#include <cstdint>
namespace cg = cooperative_groups;
namespace pg8 {
#define PG8_LAS __attribute__((address_space(3)))
typedef unsigned short bf16_t;
typedef short bf16x8 __attribute__((ext_vector_type(8)));
typedef float f32x4 __attribute__((ext_vector_type(4)));
typedef unsigned u32x4 __attribute__((ext_vector_type(4)));
constexpr int BM = 256, BK = 64, HALF = 128, HTB = HALF * BK * 2  , STAGE_BYTES = 8 * HTB, NXCD = 8, WGM = 8;

__host__ __device__ __forceinline__ int lds_byte(int r, int c) { const int st = (r >> 4) * 2 + (c >> 5), rr = r & 15, cc = c & 31, ob = rr * 64 + cc * 2; return st * 1024 + (ob ^ (((ob >> 9) & 1) << 5)); }
__host__ __device__ __forceinline__ void stage_rc(int b, int& R, int& C) { const int st = b / 1024, sb = b % 1024, swz = sb ^ (((sb >> 9) & 1) << 5); R = (st >> 1) * 16 + swz / 64; C = (st & 1) * 32 + (swz % 64) / 2; }
__host__ __device__ __forceinline__ int perm32(int rho) { const int n = rho >> 4, i = rho & 15; return 8 * (i >> 2) + 4 * n + (i & 3); }

struct Unit { int pm, pn, k0, nt; };
struct Gemm { const bf16_t* A; const bf16_t* Bt; int M, N, K; };

struct StaticOrder {
    int nM, nN, nwg, G, c, ntk;
    __host__ __device__ void init(int M, int N, int G_, int c_, int K_) { nM = M / BM; nN = N / BM; nwg = nM * nN; G = G_; c = c_; ntk = K_ / BK; }
    __host__ __device__ bool next(int i, Unit& u) const {
        const long L = (long)i * G + c; if (L >= nwg) return false;
        int wgid = (int)L; { const int q = nwg / NXCD, r = nwg % NXCD, xcd = wgid % NXCD, off = wgid / NXCD; wgid = (xcd < r ? xcd * (q + 1) : r * (q + 1) + (xcd - r) * q) + off; }
        const int nig = WGM * nN, gid = wgid / nig, fm = gid * WGM, gsz = (nM - fm) < WGM ? (nM - fm) : WGM;
        u.pm = fm + ((wgid % nig) % gsz); u.pn = (wgid % nig) / gsz; u.k0 = 0; u.nt = ntk; return true;
    }
    __device__ __forceinline__ void a_ready(const Unit&) const {}
    __device__ __forceinline__ void done(const Unit&) const {}
};
__device__ __forceinline__ unsigned cvt_pk_bf16(float lo, float hi) { unsigned r; asm volatile("v_cvt_pk_bf16_f32 %0, %1, %2" : "=v"(r) : "v"(lo), "v"(hi)); return r; }
typedef float f32x2 __attribute__((ext_vector_type(2)));
template <class Epi, class Sched, bool ALIGN_EPI = false, bool SP2 = false>
__device__ __forceinline__ void gemm_phase(PG8_LAS unsigned char* lds, const Gemm g, const Sched& S, const Epi& E, const int tid) {
    const int wid = __builtin_amdgcn_readfirstlane(tid >> 6), lane = tid & 63, wr = wid >> 2, wc = wid & 3, fr = lane & 15, fq = lane >> 4;
    const int K = g.K;
    unsigned voffA[2], voffB[2];
#pragma unroll
    for (int i = 0; i < 2; ++i) { int R, C; stage_rc(tid * 16 + i * 8192, R, C); const int Rb = Epi::PERM ? ((R & ~31) + perm32(R & 31)) : R;
        voffA[i] = (unsigned)(R * K + C) * 2u; voffB[i] = (unsigned)(Rb * K + C) * 2u; }
    const size_t kstep = (size_t)(BK * 2);
    const size_t hstep = (size_t)HALF * K * 2;
    const size_t tstep = 2 * hstep;
    const unsigned ldsw = (unsigned)wid * 1024u;
    const int aoff = lds_byte(wr * 64 + fr, fq * 8), boff = lds_byte(wc * 32 + fr, fq * 8);
#define PG8_SA(b, h) (((b) * 2 + (h)) * HTB)
#define PG8_SB(b, h) ((4 + (b) * 2 + (h)) * HTB)
#define PG8_STAGE(bufoff, gbase, voff) do { _Pragma("unroll") for (int _i = 0; _i < 2; ++_i) \
        __builtin_amdgcn_global_load_lds((const unsigned*)((const char*)(gbase) + (voff)[_i]), (PG8_LAS unsigned*)(lds + (bufoff) + ldsw + _i * 8192), 16, 0, 0); } while (0)
#define PG8_LDA(dst, b, h) do { _Pragma("unroll") for (int m = 0; m < 4; ++m) _Pragma("unroll") for (int k = 0; k < 2; ++k) dst[m][k] = *(const PG8_LAS bf16x8*)(lds + PG8_SA(b, h) + aoff + m * 2048 + k * 1024); } while (0)
#define PG8_LDB(dst, b, h) do { _Pragma("unroll") for (int n = 0; n < 2; ++n) _Pragma("unroll") for (int k = 0; k < 2; ++k) dst[n][k] = *(const PG8_LAS bf16x8*)(lds + PG8_SB(b, h) + boff + n * 2048 + k * 1024); } while (0)
#define PG8_MMA(ai, bj, At, Bt) do { __builtin_amdgcn_s_setprio(1); _Pragma("unroll") for (int m = 0; m < 4; ++m) _Pragma("unroll") for (int n = 0; n < 2; ++n) _Pragma("unroll") for (int k = 0; k < 2; ++k) \
        acc[ai][bj][m][n] = __builtin_amdgcn_mfma_f32_16x16x32_bf16(Bt[n][k], At[m][k], acc[ai][bj][m][n], 0, 0, 0); __builtin_amdgcn_s_setprio(0); } while (0)
#define PG8_WAIT_V(n) asm volatile("s_waitcnt vmcnt(" #n ")" ::: "memory")
#define PG8_WAIT_L(n) asm volatile("s_waitcnt lgkmcnt(" #n ")" ::: "memory")
#define PG8_BAR __builtin_amdgcn_s_barrier()
#define PG8_SCHED __builtin_amdgcn_sched_barrier(0)
    Unit cur, nxt; int ui = 0;
    if (!S.next(0, cur)) return;
    f32x4 acc[2][2][4][2];
#pragma unroll
    for (int a = 0; a < 2; ++a)
#pragma unroll
        for (int b = 0; b < 2; ++b)
#pragma unroll
            for (int m = 0; m < 4; ++m)
#pragma unroll
                for (int n = 0; n < 2; ++n) acc[a][b][m][n] = (f32x4){0.f, 0.f, 0.f, 0.f};
    bf16x8 At[4][2], B0[2][2], B1[2][2];
    const char* cA = (const char*)g.A + (size_t)cur.pm * tstep + (size_t)cur.k0 * kstep; const char* cB = (const char*)g.Bt + (size_t)cur.pn * tstep + (size_t)cur.k0 * kstep;
    S.a_ready(cur);
    if constexpr (SP2) {
        PG8_STAGE(PG8_SB(0, 0), cB, voffB); PG8_STAGE(PG8_SB(0, 1), cB + hstep, voffB); PG8_STAGE(PG8_SA(0, 0), cA, voffA); PG8_STAGE(PG8_SA(0, 1), cA + hstep, voffA);
        if (wr == 1) PG8_BAR;
        PG8_WAIT_V(2); PG8_BAR;
        PG8_STAGE(PG8_SB(1, 0), cB + kstep, voffB); PG8_STAGE(PG8_SA(1, 0), cA + kstep, voffA); PG8_STAGE(PG8_SB(1, 1), cB + hstep + kstep, voffB);
        PG8_WAIT_V(6); PG8_BAR;
    } else {
        PG8_STAGE(PG8_SB(0, 0), cB, voffB); PG8_STAGE(PG8_SA(0, 0), cA, voffA); PG8_STAGE(PG8_SB(0, 1), cB + hstep, voffB); PG8_STAGE(PG8_SA(0, 1), cA + hstep, voffA);
        if (wr == 1) PG8_BAR;
        PG8_WAIT_V(4); PG8_BAR;
        PG8_STAGE(PG8_SB(1, 0), cB + kstep, voffB); PG8_STAGE(PG8_SA(1, 0), cA + kstep, voffA); PG8_STAGE(PG8_SB(1, 1), cB + hstep + kstep, voffB);
        PG8_WAIT_V(6); PG8_BAR;
    }
    for (;;) {
        const bool has_next = S.next(ui + 1, nxt);
        const char* nA = has_next ? (const char*)g.A + (size_t)nxt.pm * tstep + (size_t)nxt.k0 * kstep : cA; const char* nB = has_next ? (const char*)g.Bt + (size_t)nxt.pn * tstep + (size_t)nxt.k0 * kstep : cB;
        const int nt = cur.nt;
        for (int t = 0; t < nt; t += 2) {
            const bool last = (t == nt - 2);
            const char* a1 = cA + (size_t)(t + 1) * kstep;
            const char* a2 = last ? nA : cA + (size_t)(t + 2) * kstep; const char* b2 = last ? nB : cB + (size_t)(t + 2) * kstep;
            const char* a3 = a2 + kstep; const char* b3 = b2 + kstep;
            if (last && has_next) S.a_ready(nxt);
            if constexpr (SP2) {
            PG8_LDB(B0, 0, 0); PG8_LDB(B1, 0, 1); PG8_SCHED; PG8_LDA(At, 0, 0); PG8_STAGE(PG8_SA(1, 1), a1 + hstep, voffA);
            PG8_WAIT_V(8); PG8_WAIT_L(0); PG8_BAR; PG8_MMA(0, 0, At, B0); PG8_MMA(0, 1, At, B1); PG8_BAR; PG8_SCHED;
            PG8_LDA(At, 0, 1); PG8_STAGE(PG8_SB(0, 0), b2, voffB); PG8_STAGE(PG8_SB(0, 1), b2 + hstep, voffB); PG8_STAGE(PG8_SA(0, 0), a2, voffA);
            PG8_WAIT_V(8); PG8_WAIT_L(0); PG8_BAR; PG8_MMA(1, 0, At, B0); PG8_MMA(1, 1, At, B1); PG8_BAR; PG8_SCHED;
            PG8_LDB(B0, 1, 0); PG8_LDB(B1, 1, 1); PG8_SCHED; PG8_LDA(At, 1, 0); PG8_STAGE(PG8_SA(0, 1), a2 + hstep, voffA);
            PG8_WAIT_V(8); PG8_WAIT_L(0); PG8_BAR; PG8_MMA(0, 0, At, B0); PG8_MMA(0, 1, At, B1); PG8_BAR; PG8_SCHED;
            PG8_LDA(At, 1, 1); PG8_STAGE(PG8_SB(1, 0), b3, voffB); PG8_STAGE(PG8_SB(1, 1), b3 + hstep, voffB); PG8_STAGE(PG8_SA(1, 0), a3, voffA);
            PG8_WAIT_V(8); PG8_WAIT_L(0); PG8_BAR; PG8_MMA(1, 0, At, B0); PG8_MMA(1, 1, At, B1); PG8_BAR; PG8_SCHED;
            } else {
            PG8_LDB(B0, 0, 0); PG8_SCHED; PG8_LDA(At, 0, 0); PG8_STAGE(PG8_SA(1, 1), a1 + hstep, voffA);
            PG8_WAIT_L(8); PG8_BAR; PG8_WAIT_L(0); PG8_MMA(0, 0, At, B0); PG8_BAR; PG8_SCHED;
            PG8_LDB(B1, 0, 1); PG8_STAGE(PG8_SB(0, 0), b2, voffB);
            PG8_BAR; PG8_WAIT_L(0); PG8_MMA(0, 1, At, B1); PG8_BAR;
            PG8_LDA(At, 0, 1); PG8_STAGE(PG8_SA(0, 0), a2, voffA);
            PG8_BAR; PG8_WAIT_L(0); PG8_MMA(1, 0, At, B0); PG8_BAR; PG8_SCHED;
            PG8_STAGE(PG8_SB(0, 1), b2 + hstep, voffB);
            PG8_WAIT_V(6); PG8_BAR; PG8_MMA(1, 1, At, B1); PG8_BAR;
            PG8_LDB(B0, 1, 0); PG8_SCHED; PG8_LDA(At, 1, 0); PG8_STAGE(PG8_SA(0, 1), a2 + hstep, voffA);
            PG8_WAIT_L(8); PG8_BAR; PG8_WAIT_L(0); PG8_MMA(0, 0, At, B0); PG8_BAR; PG8_SCHED;
            PG8_LDB(B1, 1, 1); PG8_STAGE(PG8_SB(1, 0), b3, voffB);
            PG8_BAR; PG8_WAIT_L(0); PG8_MMA(0, 1, At, B1); PG8_BAR;
            PG8_LDA(At, 1, 1); PG8_STAGE(PG8_SA(1, 0), a3, voffA);
            PG8_BAR; PG8_WAIT_L(0); PG8_MMA(1, 0, At, B0); PG8_BAR; PG8_SCHED;
            PG8_STAGE(PG8_SB(1, 1), b3 + hstep, voffB);
            PG8_WAIT_V(6); PG8_BAR; PG8_MMA(1, 1, At, B1); PG8_BAR;
            }
        }
        if constexpr (ALIGN_EPI) { if (wr == 0) PG8_BAR; }
        if constexpr (!Epi::AFTER_DRAIN) { E(acc, cur, wr, wc, fr, fq); S.done(cur); }
        if (!has_next) break;
#pragma unroll
        for (int a = 0; a < 2; ++a)
#pragma unroll
            for (int b = 0; b < 2; ++b)
#pragma unroll
                for (int m = 0; m < 4; ++m)
#pragma unroll
                    for (int n = 0; n < 2; ++n) acc[a][b][m][n] = (f32x4){0.f, 0.f, 0.f, 0.f};
        cur = nxt; cA = nA; cB = nB; ++ui;
        if constexpr (ALIGN_EPI) { if (wr == 1) PG8_BAR; }
    }
    PG8_WAIT_V(0);
    if constexpr (!ALIGN_EPI) { if (wr == 0) PG8_BAR; }
    PG8_BAR;
    if constexpr (Epi::AFTER_DRAIN) { E.fused(acc, cur, wr, wc, fr, fq, lds, wid, lane); S.done(cur); }
#undef PG8_SA
#undef PG8_SB
#undef PG8_STAGE
#undef PG8_LDA
#undef PG8_LDB
#undef PG8_MMA
#undef PG8_WAIT_V
#undef PG8_WAIT_L
#undef PG8_BAR
#undef PG8_SCHED
}
}

constexpr int D = 1024, NP = 16384, NS = 1024, M = NP + NS, NIN = 4096, FF = 4096, TP = 2048;
constexpr float EPS = 1e-6f;
constexpr int NWAVES = 8, NTHR = 512;
#ifndef MK_N_LAUNCHES
#define MK_N_LAUNCHES 1
#endif
constexpr int N_PHASES = 7;
#ifndef PROBE_MASK
#define PROBE_MASK 0
#endif
#define NREP(k) (((PROBE_MASK >> (k)) & 1) ? 2 : 1)
constexpr size_t MiB = 1u << 20;
constexpr size_t WS_EF = 0;
constexpr size_t WS_WIN = 1 * MiB, WS_WOUT = 9 * MiB, WS_WUP = 11 * MiB, WS_WDN = 19 * MiB, WS_TAB = 27 * MiB, WS_SSQ = 29 * MiB;
constexpr size_t WS_XN = 32 * MiB;
constexpr size_t WS_PROJ = 66 * MiB;
constexpr size_t WS_OB = 202 * MiB;
constexpr size_t WS_CTL = 236 * MiB, CTL_BYTES = 65536;
constexpr size_t WS_END = 237 * MiB;
constexpr size_t OUT_Y = 0, OUT_RSP = (size_t)M * D, OUT_HSP = OUT_RSP + 8 * 4 * 16384, OUT_RSS = OUT_HSP + 8 * 4 * 16384, OUT_HSS = OUT_RSS + (size_t)128 * 4 * 16384;
constexpr int LDS_BYTES = 147456;

#define LAS __attribute__((address_space(3)))
typedef unsigned short bf16;
typedef unsigned v4u __attribute__((ext_vector_type(4)));
typedef unsigned v2u __attribute__((ext_vector_type(2)));
typedef float f32x4 __attribute__((ext_vector_type(4)));
#define LDS_WAIT() asm volatile("s_waitcnt lgkmcnt(0)" ::: "memory")

__device__ __forceinline__ unsigned f2bf(float f) { unsigned u = __builtin_bit_cast(unsigned, f); return (u + 0x7fffu + ((u >> 16) & 1u)) >> 16; }
__device__ __forceinline__ unsigned pk2(float lo, float hi) { return f2bf(lo) | (f2bf(hi) << 16); }
typedef float f32x2_t __attribute__((ext_vector_type(2)));
typedef __bf16 bf16x2_t __attribute__((ext_vector_type(2)));
__device__ __forceinline__ unsigned cvtpk(float lo, float hi) { const f32x2_t v = {lo, hi}; const bf16x2_t b = __builtin_convertvector(v, bf16x2_t); return __builtin_bit_cast(unsigned, b); }
__device__ __forceinline__ float bflo(unsigned u) { return __uint_as_float(u << 16); }
__device__ __forceinline__ float bfhi(unsigned u) { return __uint_as_float(u & 0xffff0000u); }
__device__ __forceinline__ float sigmoidf_(float x) { return __builtin_amdgcn_rcpf(1.0f + __expf(-x)); }
__device__ __forceinline__ float siluf_(float x) { return x * sigmoidf_(x); }
__device__ __forceinline__ float wave_sum(float v) {
#pragma unroll
    for (int o = 1; o < 64; o <<= 1) v += __shfl_xor(v, o);
    return v;
}
__device__ __forceinline__ float log2gamma(int h) { return h == 0 ? -0.04580368961312479f : (h == 1 ? -0.02272007650008353f : (h == 2 ? -0.011315313227834146f : -0.005646563141142063f)); }

__constant__ double INVF[64] = {1.0, 0.8659643233600653, 0.7498942093324559, 0.6493816315762113, 0.5623413251903491, 0.4869675251658631, 0.4216965034285822, 0.3651741272548377, 0.31622776601683794, 0.27384196342643613, 0.23713737056616552, 0.2053525026457146, 0.1778279410038923, 0.1539926526059492, 0.1333521432163324, 0.11547819846894582, 0.1, 0.08659643233600653, 0.07498942093324558, 0.06493816315762113, 0.05623413251903491, 0.04869675251658631, 0.042169650342858224, 0.03651741272548377, 0.03162277660168379, 0.027384196342643614, 0.023713737056616554, 0.02053525026457146, 0.01778279410038923, 0.01539926526059492, 0.01333521432163324, 0.011547819846894581, 0.01, 0.008659643233600654, 0.007498942093324558, 0.006493816315762113, 0.005623413251903491, 0.004869675251658631, 0.004216965034285823, 0.003651741272548377, 0.0031622776601683794, 0.0027384196342643613, 0.0023713737056616554, 0.002053525026457146, 0.0017782794100389228, 0.001539926526059492, 0.001333521432163324, 0.0011547819846894581, 0.001, 0.0008659643233600654, 0.0007498942093324559, 0.0006493816315762113, 0.0005623413251903491, 0.0004869675251658631, 0.00042169650342858224, 0.0003651741272548377, 0.00031622776601683794, 0.0002738419634264361, 0.00023713737056616554, 0.0002053525026457146, 0.00017782794100389227, 0.0001539926526059492, 0.0001333521432163324, 0.00011547819846894582};

using pg8::Unit;

struct EpiProj {
    static constexpr bool PERM = true, AFTER_DRAIN = false;
    bf16* P; const float* tab; const float* lbl; unsigned* hcnt;
    __device__ __forceinline__ void operator()(const f32x4 (&acc)[2][2][4][2], const Unit& u, int wr, int wc, int fr, int fq) const {
        const int type = u.pn >> 1;
        const int row0 = u.pm * 256 + wr * 64 + fr, d0 = wc * 32 + 8 * fq, col0 = u.pn * 256 + d0;
        if (type <= 1) {
#pragma unroll
            for (int ai = 0; ai < 2; ++ai)
#pragma unroll
                for (int m = 0; m < 4; ++m) {
                    const int row = row0 + ai * 128 + m * 16;
                    const int pidx = row < NP ? (row & (TP - 1)) : TP + (row & 7);
                    const f32x4* tp = (const f32x4*)(tab + ((size_t)pidx * 64 + (d0 >> 1)) * 2);
                    const f32x4 cs0 = tp[0], cs1 = tp[1];
                    bf16* rowp = P + (size_t)row * NIN + col0;
#pragma unroll
                    for (int bj = 0; bj < 2; ++bj) {
                        float sc = 1.0f;
                        if (type == 1) { sc = 0.08838834764831845f; if (row < NP) sc *= exp2f(-(float)((row & 63) + 1) * log2gamma(2 * (u.pn & 1) + bj)); }
                        const f32x4 v0 = acc[ai][bj][m][0], v1 = acc[ai][bj][m][1];
                        v4u w;
                        w.x = cvtpk((v0[0] * cs0[0] - v0[1] * cs0[1]) * sc, (v0[0] * cs0[1] + v0[1] * cs0[0]) * sc);
                        w.y = cvtpk((v0[2] * cs0[2] - v0[3] * cs0[3]) * sc, (v0[2] * cs0[3] + v0[3] * cs0[2]) * sc);
                        w.z = cvtpk((v1[0] * cs1[0] - v1[1] * cs1[1]) * sc, (v1[0] * cs1[1] + v1[1] * cs1[0]) * sc);
                        w.w = cvtpk((v1[2] * cs1[2] - v1[3] * cs1[3]) * sc, (v1[2] * cs1[3] + v1[3] * cs1[2]) * sc);
                        *(v4u*)(rowp + bj * 128) = w;
                    }
                    if (m == 3) asm volatile("" ::: "memory");
                }
        } else if (type == 5) {
            float lb[2][8];
#pragma unroll
            for (int bj = 0; bj < 2; ++bj)
#pragma unroll
                for (int i = 0; i < 8; ++i) { const int c = (u.pn & 1) * 256 + bj * 128 + d0 + i; lb[bj][i] = sigmoidf_(lbl[c] - lbl[512 + c]); }
#pragma unroll
            for (int ai = 0; ai < 2; ++ai)
#pragma unroll
                for (int m = 0; m < 4; ++m) {
                    const int row = row0 + ai * 128 + m * 16;
                    bf16* rowp = P + (size_t)row * NIN + col0;
#pragma unroll
                    for (int bj = 0; bj < 2; ++bj) {
                        float o[8];
#pragma unroll
                        for (int i = 0; i < 8; ++i) { const float x = acc[ai][bj][m][i >> 2][i & 3]; const float f = lb[bj][i] + (1.0f - lb[bj][i]) * sigmoidf_(x); o[i] = __logf(f); }
                        v4u w; w.x = cvtpk(o[0], o[1]); w.y = cvtpk(o[2], o[3]); w.z = cvtpk(o[4], o[5]); w.w = cvtpk(o[6], o[7]);
                        *(v4u*)(rowp + bj * 128) = w;
                    }
                }
        } else {
            const bool act = (type == 3) || (type == 4) || (type == 7);
            const float sc = (type == 4) ? 0.08838834764831845f : 1.0f;
#pragma unroll
            for (int ai = 0; ai < 2; ++ai)
#pragma unroll
                for (int m = 0; m < 4; ++m) {
                    const int row = row0 + ai * 128 + m * 16;
                    bf16* rowp = P + (size_t)row * NIN + col0;
#pragma unroll
                    for (int bj = 0; bj < 2; ++bj) {
                        float o[8];
#pragma unroll
                        for (int i = 0; i < 8; ++i) { const float x = acc[ai][bj][m][i >> 2][i & 3]; o[i] = act ? siluf_(x) * sc : x; }
                        v4u w; w.x = cvtpk(o[0], o[1]); w.y = cvtpk(o[2], o[3]); w.z = cvtpk(o[4], o[5]); w.w = cvtpk(o[6], o[7]);
                        *(v4u*)(rowp + bj * 128) = w;
                    }
                }
        }
        if ((type == 4 || type == 5) && u.pm < NP / 256) {
            asm volatile("s_waitcnt vmcnt(0)" ::: "memory");
            __syncthreads();
            if (threadIdx.x == 0) {
                __builtin_amdgcn_fence(__ATOMIC_RELEASE, "agent");
                asm volatile("s_waitcnt vmcnt(0)" ::: "memory");
                __hip_atomic_fetch_add(hcnt, 1u, __ATOMIC_RELAXED, __HIP_MEMORY_SCOPE_AGENT);
            }
        }
    }
};

constexpr int OUT_SPLIT = 4;
struct EpiOut {
    static constexpr bool PERM = true, AFTER_DRAIN = false;
    const float* xp; const float* xs; float* X1; bf16* X1B; float* ssq; float* PART;
    __device__ __forceinline__ void operator()(const f32x4 (&acc)[2][2][4][2], const Unit& u, int wr, int wc, int fr, int fq) const {
        const int row0 = u.pm * 256 + wr * 64 + fr, col0 = u.pn * 256 + wc * 32 + 8 * fq;
        if (u.nt != D / 64) {
            float* pb = PART + (size_t)(u.k0 / u.nt) * ((size_t)NS * D);
#pragma unroll
            for (int ai = 0; ai < 2; ++ai)
#pragma unroll
                for (int m = 0; m < 4; ++m) {
                    float* op = pb + (size_t)(row0 - NP + ai * 128 + m * 16) * D + col0;
#pragma unroll
                    for (int bj = 0; bj < 2; ++bj) { *(f32x4*)(op + bj * 128) = acc[ai][bj][m][0]; *(f32x4*)(op + bj * 128 + 4) = acc[ai][bj][m][1]; }
                }
            return;
        }
#pragma unroll
        for (int ai = 0; ai < 2; ++ai)
#pragma unroll
            for (int m = 0; m < 4; ++m) {
                const int row = row0 + ai * 128 + m * 16;
                const float* xr = (row < NP ? xp + (size_t)row * D : xs + (size_t)(row - NP) * D) + col0;
                bf16* bp = X1B + (size_t)row * D + col0;
                float s = 0.f;
#pragma unroll
                for (int bj = 0; bj < 2; ++bj) {
                    const f32x4 v0 = acc[ai][bj][m][0] + __builtin_nontemporal_load((const f32x4*)(xr + bj * 128)), v1 = acc[ai][bj][m][1] + __builtin_nontemporal_load((const f32x4*)(xr + bj * 128 + 4));
                    v4u w; w.x = cvtpk(v0[0], v0[1]); w.y = cvtpk(v0[2], v0[3]); w.z = cvtpk(v1[0], v1[1]); w.w = cvtpk(v1[2], v1[3]);
                    *(v4u*)(bp + bj * 128) = w;
                    s += (v0[0] * v0[0] + v0[1] * v0[1]) + (v0[2] * v0[2] + v0[3] * v0[3]) + (v1[0] * v1[0] + v1[1] * v1[1]) + (v1[2] * v1[2] + v1[3] * v1[3]);
                }
                s += __shfl_xor(s, 16); s += __shfl_xor(s, 32);
                if (fq == 0) ssq[(size_t)row * 16 + u.pn * 4 + wc] = s;
                if (m == 3) asm volatile("" ::: "memory");
            }
    }
};

struct OutOrder {
    int G, c; pg8::StaticOrder P;
    __host__ __device__ void init(int G_, int c_) { G = G_; c = c_; P.init(NP, D, G_, c_, D); }
    __host__ __device__ bool next(int i, Unit& u) const {
        const int L = i * G + c;
        if (L < 256) return P.next(i, u);
        const int s = L - 256; if (s >= 16 * OUT_SPLIT) return false;
        const int tile = s / OUT_SPLIT, ks = s % OUT_SPLIT;
        u.pm = NP / 256 + (tile >> 2); u.pn = tile & 3; u.nt = (D / 64) / OUT_SPLIT; u.k0 = ks * u.nt; return true;
    }
    __device__ __forceinline__ void a_ready(const Unit&) const {}
    __device__ __forceinline__ void done(const Unit&) const {}
};
__device__ __forceinline__ void sample_out_reduce(const float* xrow, const float* part, float* x1row, bf16* x1brow, float* r2out, int lane) {
    f32x4 v[4]; float s = 0.f;
#pragma unroll
    for (int j = 0; j < 4; ++j) v[j] = ((const f32x4*)xrow)[lane + 64 * j];
#pragma unroll
    for (int ks = 0; ks < OUT_SPLIT; ++ks)
#pragma unroll
        for (int j = 0; j < 4; ++j) v[j] += __builtin_nontemporal_load((const f32x4*)(part + (size_t)ks * NS * D) + lane + 64 * j);
#pragma unroll
    for (int j = 0; j < 4; ++j) { s += (v[j][0] * v[j][0] + v[j][1] * v[j][1]) + (v[j][2] * v[j][2] + v[j][3] * v[j][3]); ((f32x4*)x1row)[lane + 64 * j] = v[j];
        ((unsigned long long*)x1brow)[lane + 64 * j] = (unsigned long long)cvtpk(v[j][0], v[j][1]) | ((unsigned long long)cvtpk(v[j][2], v[j][3]) << 32); }
    s = wave_sum(s);
    if (lane == 0) *r2out = 1.0f / (s * (1.0f / D) + EPS);
}

struct EpiUp {
    static constexpr bool PERM = true, AFTER_DRAIN = false;
    bf16* H; const float* r2v;
    __device__ __forceinline__ void operator()(const f32x4 (&acc)[2][2][4][2], const Unit& u, int wr, int wc, int fr, int fq) const {
        const int row0 = u.pm * 256 + wr * 64 + fr, col0 = u.pn * 256 + wc * 32 + 8 * fq;
        float r2[2][4];
#pragma unroll
        for (int ai = 0; ai < 2; ++ai)
#pragma unroll
            for (int m = 0; m < 4; ++m) r2[ai][m] = r2v[row0 + ai * 128 + m * 16];
#pragma unroll
        for (int ai = 0; ai < 2; ++ai)
#pragma unroll
            for (int m = 0; m < 4; ++m) {
                const int row = row0 + ai * 128 + m * 16;
                bf16* hp = H + (size_t)row * FF + col0;
#pragma unroll
                for (int bj = 0; bj < 2; ++bj) {
                    float o[8];
#pragma unroll
                    for (int i = 0; i < 8; ++i) { const float x = fmaxf(acc[ai][bj][m][i >> 2][i & 3], 0.f); o[i] = x * x * r2[ai][m]; }
                    v4u w; w.x = cvtpk(o[0], o[1]); w.y = cvtpk(o[2], o[3]); w.z = cvtpk(o[4], o[5]); w.w = cvtpk(o[6], o[7]);
                    *(v4u*)(hp + bj * 128) = w;
                }
            }
    }
};

constexpr int DN_SPLIT = 8;
struct EpiDown {
    static constexpr bool PERM = true, AFTER_DRAIN = false;
    bf16* XB; float* PART;
    __device__ __forceinline__ void operator()(const f32x4 (&acc)[2][2][4][2], const Unit& u, int wr, int wc, int fr, int fq) const {
        const int row0 = u.pm * 256 + wr * 64 + fr, col0 = u.pn * 256 + wc * 32 + 8 * fq;
        if (u.nt == FF / 64) {
#pragma unroll
            for (int ai = 0; ai < 2; ++ai)
#pragma unroll
                for (int m = 0; m < 4; ++m) {
                    bf16* op = XB + (size_t)(row0 + ai * 128 + m * 16) * D + col0;
#pragma unroll
                    for (int bj = 0; bj < 2; ++bj) {
                        const v4u b = *(const v4u*)(op + bj * 128);
                        const f32x4 v0 = acc[ai][bj][m][0] + (f32x4){bflo(b.x), bfhi(b.x), bflo(b.y), bfhi(b.y)}, v1 = acc[ai][bj][m][1] + (f32x4){bflo(b.z), bfhi(b.z), bflo(b.w), bfhi(b.w)};
                        *(v4u*)(op + bj * 128) = (v4u){cvtpk(v0[0], v0[1]), cvtpk(v0[2], v0[3]), cvtpk(v1[0], v1[1]), cvtpk(v1[2], v1[3])};
                    }
                }
        } else {
            float* pb = PART + (size_t)(u.k0 / u.nt) * ((size_t)NS * D);
#pragma unroll
            for (int ai = 0; ai < 2; ++ai)
#pragma unroll
                for (int m = 0; m < 4; ++m) {
                    float* op = pb + (size_t)(row0 - NP + ai * 128 + m * 16) * D + col0;
#pragma unroll
                    for (int bj = 0; bj < 2; ++bj) { *(f32x4*)(op + bj * 128) = acc[ai][bj][m][0]; *(f32x4*)(op + bj * 128 + 4) = acc[ai][bj][m][1]; }
                }
        }
    }
};
struct DownOrder {
    int G, c; pg8::StaticOrder P;
    __host__ __device__ void init(int G_, int c_) { G = G_; c = c_; P.init(NP, D, G_, c_, FF); }
    __host__ __device__ bool next(int i, Unit& u) const {
        const int L = i * G + c;
        if (L < 256) return P.next(i, u);
        const int s = L - 256; if (s >= 16 * DN_SPLIT) return false;
        const int tile = s / DN_SPLIT, ks = s % DN_SPLIT;
        u.pm = NP / 256 + (tile >> 2); u.pn = tile & 3; u.nt = (FF / 64) / DN_SPLIT; u.k0 = ks * u.nt; return true;
    }
    __device__ __forceinline__ void a_ready(const Unit&) const {}
    __device__ __forceinline__ void done(const Unit&) const {}
};

__device__ __forceinline__ int wmap_in(int n) { if (n < 1024) { const int d = n & 127; return (n & ~127) | ((d & 63) << 1) | (d >> 6); } return n; }
template <bool MAP>
__device__ __forceinline__ void p0_transpose_item(const float* W, int K, int N, bf16* WT, const float* kscale, LAS float* scr, int item, int lane) {
    const int nblk = N / 32, kb = item / nblk, nb = item % nblk, k0 = 64 * kb, n0 = 32 * nb;
    f32x4 wv[8];
#pragma unroll
    for (int i = 0; i < 8; ++i) wv[i] = __builtin_nontemporal_load((const f32x4*)(W + (size_t)(k0 + 8 * i + (lane >> 3)) * N + n0 + 4 * (lane & 7)));
#pragma unroll
    for (int i = 0; i < 8; ++i) { const int kk = 8 * i + (lane >> 3); f32x4 w = wv[i]; if (kscale) w *= kscale[k0 + kk];
        LAS float* d = scr + kk * 33 + 4 * (lane & 7); d[0] = w[0]; d[1] = w[1]; d[2] = w[2]; d[3] = w[3]; }
    LDS_WAIT(); asm volatile("" ::: "memory");
    const int c = lane & 7;
#pragma unroll
    for (int j = 0; j < 4; ++j) { const int n = (lane >> 3) + 8 * j; const LAS float* s = scr + (8 * c) * 33 + n;
        v4u o; o.x = cvtpk(s[0 * 33], s[1 * 33]); o.y = cvtpk(s[2 * 33], s[3 * 33]); o.z = cvtpk(s[4 * 33], s[5 * 33]); o.w = cvtpk(s[6 * 33], s[7 * 33]);
        const int nd = MAP ? wmap_in(n0 + n) : (n0 + n);
        *(v4u*)(WT + (size_t)nd * K + k0 + 8 * c) = o; }
    LDS_WAIT(); asm volatile("" ::: "memory");
}
__device__ __forceinline__ void rms_row_to_bf16(const float* xrow, const float* w, bf16* orow, int lane) {
    const f32x4* xr = (const f32x4*)xrow + lane; const f32x4* wr_ = (const f32x4*)w + lane;
    f32x4 v[4]; float s = 0.f;
#pragma unroll
    for (int j = 0; j < 4; ++j) { v[j] = __builtin_nontemporal_load(xr + 64 * j); s += (v[j][0] * v[j][0] + v[j][1] * v[j][1]) + (v[j][2] * v[j][2] + v[j][3] * v[j][3]); }
    const float rstd = rsqrtf(wave_sum(s) * (1.f / D) + EPS);
    unsigned long long* o8 = (unsigned long long*)orow + lane;
#pragma unroll
    for (int j = 0; j < 4; ++j) { const f32x4 ww = wr_[64 * j]; const f32x4 o = v[j] * rstd * ww; o8[64 * j] = (unsigned long long)cvtpk(o[0], o[1]) | ((unsigned long long)cvtpk(o[2], o[3]) << 32); }
}
__device__ __forceinline__ void rms_row_from_bf16(const bf16* xrow, float* yrow, const float* w, int lane) {
    const unsigned long long* xr = (const unsigned long long*)xrow + lane; const f32x4* wr_ = (const f32x4*)w + lane;
    f32x4 v[4]; float s = 0.f;
#pragma unroll
    for (int j = 0; j < 4; ++j) { const unsigned long long u = xr[64 * j]; const unsigned lo = (unsigned)u, hi = (unsigned)(u >> 32); v[j] = (f32x4){bflo(lo), bfhi(lo), bflo(hi), bfhi(hi)}; s += (v[j][0] * v[j][0] + v[j][1] * v[j][1]) + (v[j][2] * v[j][2] + v[j][3] * v[j][3]); }
    const float rstd = rsqrtf(wave_sum(s) * (1.f / D) + EPS);
#pragma unroll
    for (int j = 0; j < 4; ++j) ((f32x4*)yrow)[lane + 64 * j] = v[j] * rstd * wr_[64 * j];
}
__device__ __forceinline__ void rms_row2_from_bf16(const bf16* xa, float* ya, const bf16* xb, float* yb, const float* w, int lane) {
    const unsigned long long* pa = (const unsigned long long*)xa + lane; const unsigned long long* pb = (const unsigned long long*)(xb ? xb : xa) + lane; const f32x4* wr_ = (const f32x4*)w + lane;
    unsigned long long ua[4], ub[4];
#pragma unroll
    for (int j = 0; j < 4; ++j) { ua[j] = __builtin_nontemporal_load(pa + 64 * j); ub[j] = __builtin_nontemporal_load(pb + 64 * j); }
    f32x4 va[4], vb[4]; float sa = 0.f, sb = 0.f;
#pragma unroll
    for (int j = 0; j < 4; ++j) { const unsigned al = (unsigned)ua[j], ah = (unsigned)(ua[j] >> 32), bl = (unsigned)ub[j], bh = (unsigned)(ub[j] >> 32);
        va[j] = (f32x4){bflo(al), bfhi(al), bflo(ah), bfhi(ah)}; vb[j] = (f32x4){bflo(bl), bfhi(bl), bflo(bh), bfhi(bh)};
        sa += (va[j][0] * va[j][0] + va[j][1] * va[j][1]) + (va[j][2] * va[j][2] + va[j][3] * va[j][3]); sb += (vb[j][0] * vb[j][0] + vb[j][1] * vb[j][1]) + (vb[j][2] * vb[j][2] + vb[j][3] * vb[j][3]); }
    const float ra = rsqrtf(wave_sum(sa) * (1.f / D) + EPS), rb = rsqrtf(wave_sum(sb) * (1.f / D) + EPS);
#pragma unroll
    for (int j = 0; j < 4; ++j) { const f32x4 ww = wr_[64 * j]; __builtin_nontemporal_store(va[j] * ra * ww, (f32x4*)ya + lane + 64 * j); if (xb) __builtin_nontemporal_store(vb[j] * rb * ww, (f32x4*)yb + lane + 64 * j); }
}
__device__ __forceinline__ void rms_row_inplace(float* xrow, const float* w, int lane, const float* part) {
    f32x4* xr = (f32x4*)xrow + lane; const f32x4* wr_ = (const f32x4*)w + lane;
    f32x4 v[4]; float s = 0.f;
#pragma unroll
    for (int j = 0; j < 4; ++j) v[j] = xr[64 * j];
    if (part) {
#pragma unroll
        for (int ks = 0; ks < DN_SPLIT; ++ks)
#pragma unroll
            for (int j = 0; j < 4; ++j) v[j] += __builtin_nontemporal_load((const f32x4*)(part + (size_t)ks * NS * D) + lane + 64 * j);
    }
#pragma unroll
    for (int j = 0; j < 4; ++j) { s += (v[j][0] * v[j][0] + v[j][1] * v[j][1]) + (v[j][2] * v[j][2] + v[j][3] * v[j][3]); }
    const float rstd = rsqrtf(wave_sum(s) * (1.f / D) + EPS);
#pragma unroll
    for (int j = 0; j < 4; ++j) xr[64 * j] = v[j] * rstd * wr_[64 * j];
}

template <bool HG>
__device__ __forceinline__ void rec_unit(LAS unsigned char* lds, const bf16* proj, bf16* OB, const float* normw, size_t row0, int T, int h, bool prompt, const float* s_in, float* s_out, int tid) {
    const int w = __builtin_amdgcn_readfirstlane(tid >> 6), lane = tid & 63, dq = lane >> 2, vq = lane & 3;
    const int colq = (HG ? 2048 : 0) + 128 * h, colk = colq + 512, colv = colq + 1024, colg = colq + 1536, colo = (HG ? 512 : 0) + 128 * h;
    LAS bf16* Qs = (LAS bf16*)lds; LAS bf16* Ks = Qs + 64 * 128; LAS bf16* Vs = Ks + 64 * 128; LAS float* Os = (LAS float*)(lds + 49152);
    float S[8][4];
    const int vcol = 16 * w + 4 * vq;
#pragma unroll
    for (int i = 0; i < 8; ++i) { const int p = 8 * dq + i, d = HG ? p : ((p >> 1) + 64 * (p & 1));
        if (s_in) { const f32x4 t = *(const f32x4*)(s_in + (size_t)d * 128 + vcol); S[i][0] = t[0]; S[i][1] = t[1]; S[i][2] = t[2]; S[i][3] = t[3]; }
        else { S[i][0] = 0.f; S[i][1] = 0.f; S[i][2] = 0.f; S[i][3] = 0.f; } }
    const float l2g = log2gamma(h), gam = exp2f(l2g);
    for (int t0 = 0; t0 < T; t0 += 64) {
        const int TC = (T - t0) < 64 ? (T - t0) : 64;
        __syncthreads();
        for (int i = tid; i < TC * 16; i += NTHR) { const int r = i >> 4, c = i & 15; const bf16* src = proj + (row0 + t0 + r) * NIN + c * 8;
            *(LAS v4u*)(Qs + r * 128 + c * 8) = *(const v4u*)(src + colq); *(LAS v4u*)(Ks + r * 128 + c * 8) = *(const v4u*)(src + colk); *(LAS v4u*)(Vs + r * 128 + c * 8) = *(const v4u*)(src + colv); }
        __syncthreads();
        for (int t = 0; t < TC; ++t) {
            const v4u qu = *(const LAS v4u*)(Qs + t * 128 + 8 * dq), ku = *(const LAS v4u*)(Ks + t * 128 + 8 * dq); const v2u vu = *(const LAS v2u*)(Vs + t * 128 + vcol);
            float q[8], k[8], f[8], v[4];
            q[0] = bflo(qu.x); q[1] = bfhi(qu.x); q[2] = bflo(qu.y); q[3] = bfhi(qu.y); q[4] = bflo(qu.z); q[5] = bfhi(qu.z); q[6] = bflo(qu.w); q[7] = bfhi(qu.w);
            k[0] = bflo(ku.x); k[1] = bfhi(ku.x); k[2] = bflo(ku.y); k[3] = bfhi(ku.y); k[4] = bflo(ku.z); k[5] = bfhi(ku.z); k[6] = bflo(ku.w); k[7] = bfhi(ku.w);
            v[0] = bflo(vu.x); v[1] = bfhi(vu.x); v[2] = bflo(vu.y); v[3] = bfhi(vu.y);
            if (HG) {
#pragma unroll
                for (int i = 0; i < 8; ++i) { f[i] = __expf(k[i]); k[i] = 1.0f - f[i]; }
            } else {
                const float ks = prompt ? exp2f((float)(((t0 + t) & 63) + 1) * l2g) : 1.0f;
#pragma unroll
                for (int i = 0; i < 8; ++i) { f[i] = gam; k[i] *= ks; }
            }
            float o[4] = {0.f, 0.f, 0.f, 0.f};
#pragma unroll
            for (int i = 0; i < 8; ++i)
#pragma unroll
                for (int c = 0; c < 4; ++c) { S[i][c] = f[i] * S[i][c] + k[i] * v[c]; o[c] += q[i] * S[i][c]; }
#pragma unroll
            for (int c = 0; c < 4; ++c) { o[c] += __shfl_xor(o[c], 4); o[c] += __shfl_xor(o[c], 8); o[c] += __shfl_xor(o[c], 16); o[c] += __shfl_xor(o[c], 32); }
            if (dq == 0) *(LAS f32x4*)(Os + t * 128 + vcol) = (f32x4){o[0], o[1], o[2], o[3]};
        }
        __syncthreads();
        {
            const int r = tid >> 3, seg = tid & 7;
            if (r < TC) {
                float x[16]; float s = 0.f;
#pragma unroll
                for (int i = 0; i < 4; ++i) { const f32x4 t = *(const LAS f32x4*)(Os + r * 128 + seg * 16 + 4 * i); x[4 * i] = t[0]; x[4 * i + 1] = t[1]; x[4 * i + 2] = t[2]; x[4 * i + 3] = t[3]; s += (t[0] * t[0] + t[1] * t[1]) + (t[2] * t[2] + t[3] * t[3]); }
                s += __shfl_xor(s, 1); s += __shfl_xor(s, 2); s += __shfl_xor(s, 4);
                const float rstd = rsqrtf(s * (1.0f / 128.0f) + EPS);
                const bf16* gp = proj + (row0 + t0 + r) * NIN + colg + seg * 16;
                const v4u g0 = *(const v4u*)gp, g1 = *(const v4u*)(gp + 8);
                const unsigned gu[8] = {g0.x, g0.y, g0.z, g0.w, g1.x, g1.y, g1.z, g1.w};
                unsigned ou[8];
#pragma unroll
                for (int i = 0; i < 8; ++i) { const float a = x[2 * i] * rstd * normw[seg * 16 + 2 * i] * bflo(gu[i]), b = x[2 * i + 1] * rstd * normw[seg * 16 + 2 * i + 1] * bfhi(gu[i]); ou[i] = cvtpk(a, b); }
                bf16* op = OB + (row0 + t0 + r) * D + colo + seg * 16;
                *(v4u*)op = (v4u){ou[0], ou[1], ou[2], ou[3]}; *(v4u*)(op + 8) = (v4u){ou[4], ou[5], ou[6], ou[7]};
            }
        }
    }
#pragma unroll
    for (int i = 0; i < 8; ++i) { const int p = 8 * dq + i, d = HG ? p : ((p >> 1) + 64 * (p & 1)); *(f32x4*)(s_out + (size_t)d * 128 + vcol) = (f32x4){S[i][0], S[i][1], S[i][2], S[i][3]}; }
}


template <int CTRL, int RMASK> __device__ __forceinline__ float dpp0(float x) { return __builtin_bit_cast(float, __builtin_amdgcn_update_dpp(0, __builtin_bit_cast(int, x), CTRL, RMASK, 0xf, false)); }
__device__ __forceinline__ float wave_incl_scan(float x) {
#if !defined(SCAN_SHFL)
    x += dpp0<0x111, 0xf>(x); x += dpp0<0x112, 0xf>(x); x += dpp0<0x114, 0xf>(x); x += dpp0<0x118, 0xf>(x);
    x += dpp0<0x142, 0xa>(x); x += dpp0<0x143, 0xc>(x);
#else
    const int l_ = (int)__builtin_amdgcn_mbcnt_hi(~0u, __builtin_amdgcn_mbcnt_lo(~0u, 0u));
#pragma unroll
    for (int off = 1; off < 64; off <<= 1) { const float t = __shfl_up(x, off); if (l_ >= off) x += t; }
#endif
    return x;
}
__device__ __forceinline__ float rdlane(float x, int l) { return __builtin_bit_cast(float, __builtin_amdgcn_readlane(__builtin_bit_cast(int, x), l)); }
__device__ __forceinline__ void hg_prep_compute(const v4u qv, const v4u gv, bf16* outp, float* ef, int lane) {
    const unsigned qu[4] = {qv.x, qv.y, qv.z, qv.w}, gu[4] = {gv.x, gv.y, gv.z, gv.w};
    float qp[8], kp[8], e8[8], f8[8];
#pragma unroll
    for (int i = 0; i < 8; ++i) {
        const float q = (i & 1) ? bfhi(qu[i >> 1]) : bflo(qu[i >> 1]), gg = (i & 1) ? bfhi(gu[i >> 1]) : bflo(gu[i >> 1]);
        const float bs = wave_incl_scan(gg);
        const float b32 = rdlane(bs, 31), b63 = rdlane(bs, 63);
        float dlt = bs - b32; dlt = fminf(fmaxf(dlt, -80.f), 80.f);
        qp[i] = q * __expf(dlt); kp[i] = (1.0f - __expf(gg)) * __expf(-dlt);
        e8[i] = __expf(b32); f8[i] = __expf(b63 - b32);
    }
    *(v4u*)outp = (v4u){cvtpk(qp[0], qp[1]), cvtpk(qp[2], qp[3]), cvtpk(qp[4], qp[5]), cvtpk(qp[6], qp[7])};
    *(v4u*)(outp + 512) = (v4u){cvtpk(kp[0], kp[1]), cvtpk(kp[2], kp[3]), cvtpk(kp[4], kp[5]), cvtpk(kp[6], kp[7])};
    if (lane == 0) {
        *(f32x4*)ef = (f32x4){e8[0], e8[1], e8[2], e8[3]}; *(f32x4*)(ef + 4) = (f32x4){e8[4], e8[5], e8[6], e8[7]};
        *(f32x4*)(ef + 128) = (f32x4){f8[0], f8[1], f8[2], f8[3]}; *(f32x4*)(ef + 132) = (f32x4){f8[4], f8[5], f8[6], f8[7]};
    }
}
__device__ __forceinline__ void hg_prep_item2(const bf16* proj, bf16* qkp, float* EF, int itemA, int itemB, int lane) {
    const int ccA = itemA & 15, cA = (itemA >> 4) & 31, hA = (itemA >> 9) & 3, bA = itemA >> 11;
    const int ccB = itemB & 15, cB = (itemB >> 4) & 31, hB = (itemB >> 9) & 3, bB = itemB >> 11;
    const bf16* rA = proj + ((size_t)bA * TP + 64 * cA + lane) * NIN + 2048 + 128 * hA + 8 * ccA;
    const bf16* rB = proj + ((size_t)bB * TP + 64 * cB + lane) * NIN + 2048 + 128 * hB + 8 * ccB;
    const v4u qA = *(const v4u*)rA, gA = *(const v4u*)(rA + 512), qB = *(const v4u*)rB, gB = *(const v4u*)(rB + 512);
    hg_prep_compute(qA, gA, qkp + ((size_t)bA * TP + 64 * cA + lane) * 1024 + 128 * hA + 8 * ccA, EF + ((size_t)((bA * 4 + hA) * 32 + cA)) * 256 + 8 * ccA, lane);
    hg_prep_compute(qB, gB, qkp + ((size_t)bB * TP + 64 * cB + lane) * 1024 + 128 * hB + 8 * ccB, EF + ((size_t)((bB * 4 + hB) * 32 + cB)) * 256 + 8 * ccB, lane);
}

template <bool HG>
__device__ __forceinline__ void rec_unit8(LAS unsigned char* lds, const bf16* proj, bf16* OB, const float* normw, size_t row0, int h, const float* s_in, float* s_out, int tid) {
    const int w = __builtin_amdgcn_readfirstlane(tid >> 6), lane = tid & 63, dq = lane >> 2, vq = lane & 3;
    const int colq = (HG ? 2048 : 0) + 128 * h, colk = colq + 512, colv = colq + 1024, colg = colq + 1536, colo = (HG ? 512 : 0) + 128 * h;
    LAS bf16* Qs = (LAS bf16*)lds; LAS bf16* Ks = Qs + 64 * 128; LAS bf16* Vs = Ks + 64 * 128; LAS float* Os = (LAS float*)(lds + 49152);
    const int vcol = 16 * w + 4 * vq;
    v4u tq = (v4u){0u, 0u, 0u, 0u}, tk = tq, tv = tq, g0 = tq, g1 = tq; float nw[16];
    const int pr = tid >> 4, pcn = tid & 15;
    if (tid < 128) { const bf16* src = proj + (row0 + pr) * NIN + pcn * 8; tq = *(const v4u*)(src + colq); tk = *(const v4u*)(src + colk); tv = *(const v4u*)(src + colv); }
    const int er = tid >> 3, eseg = tid & 7;
    if (tid < 64) { const bf16* gp = proj + (row0 + er) * NIN + colg + eseg * 16; g0 = *(const v4u*)gp; g1 = *(const v4u*)(gp + 8); }
#pragma unroll
    for (int i = 0; i < 16; ++i) nw[i] = normw[eseg * 16 + i];
    float S[8][4];
#pragma unroll
    for (int i = 0; i < 8; ++i) { const int p = 8 * dq + i, d = HG ? p : ((p >> 1) + 64 * (p & 1));
        const f32x4 t = *(const f32x4*)(s_in + (size_t)d * 128 + vcol); S[i][0] = t[0]; S[i][1] = t[1]; S[i][2] = t[2]; S[i][3] = t[3]; }
    const float gam = exp2f(log2gamma(h));
    __syncthreads();
    if (tid < 128) { *(LAS v4u*)(Qs + pr * 128 + pcn * 8) = tq; *(LAS v4u*)(Ks + pr * 128 + pcn * 8) = tk; *(LAS v4u*)(Vs + pr * 128 + pcn * 8) = tv; }
    __syncthreads();
#pragma unroll 2
    for (int t = 0; t < 8; ++t) {
        const v4u qu = *(const LAS v4u*)(Qs + t * 128 + 8 * dq), ku = *(const LAS v4u*)(Ks + t * 128 + 8 * dq); const v2u vu = *(const LAS v2u*)(Vs + t * 128 + vcol);
        float q[8], k[8], f[8], v[4];
        q[0] = bflo(qu.x); q[1] = bfhi(qu.x); q[2] = bflo(qu.y); q[3] = bfhi(qu.y); q[4] = bflo(qu.z); q[5] = bfhi(qu.z); q[6] = bflo(qu.w); q[7] = bfhi(qu.w);
        k[0] = bflo(ku.x); k[1] = bfhi(ku.x); k[2] = bflo(ku.y); k[3] = bfhi(ku.y); k[4] = bflo(ku.z); k[5] = bfhi(ku.z); k[6] = bflo(ku.w); k[7] = bfhi(ku.w);
        v[0] = bflo(vu.x); v[1] = bfhi(vu.x); v[2] = bflo(vu.y); v[3] = bfhi(vu.y);
        if (HG) {
#pragma unroll
            for (int i = 0; i < 8; ++i) { f[i] = __expf(k[i]); k[i] = 1.0f - f[i]; }
        } else {
#pragma unroll
            for (int i = 0; i < 8; ++i) f[i] = gam;
        }
        float o[4] = {0.f, 0.f, 0.f, 0.f};
#pragma unroll
        for (int i = 0; i < 8; ++i)
#pragma unroll
            for (int c = 0; c < 4; ++c) { S[i][c] = f[i] * S[i][c] + k[i] * v[c]; o[c] += q[i] * S[i][c]; }
#pragma unroll
        for (int c = 0; c < 4; ++c) { o[c] += __shfl_xor(o[c], 4); o[c] += __shfl_xor(o[c], 8); o[c] += __shfl_xor(o[c], 16); o[c] += __shfl_xor(o[c], 32); }
        if (dq == 0) *(LAS f32x4*)(Os + t * 128 + vcol) = (f32x4){o[0], o[1], o[2], o[3]};
    }
    __syncthreads();
    if (tid < 64) {
        float x[16]; float s = 0.f;
#pragma unroll
        for (int i = 0; i < 4; ++i) { const f32x4 t = *(const LAS f32x4*)(Os + er * 128 + eseg * 16 + 4 * i); x[4 * i] = t[0]; x[4 * i + 1] = t[1]; x[4 * i + 2] = t[2]; x[4 * i + 3] = t[3]; s += (t[0] * t[0] + t[1] * t[1]) + (t[2] * t[2] + t[3] * t[3]); }
        s += __shfl_xor(s, 1); s += __shfl_xor(s, 2); s += __shfl_xor(s, 4);
        const float rstd = rsqrtf(s * (1.0f / 128.0f) + EPS);
        const unsigned gu[8] = {g0.x, g0.y, g0.z, g0.w, g1.x, g1.y, g1.z, g1.w};
        unsigned ou[8];
#pragma unroll
        for (int i = 0; i < 8; ++i) { const float a = x[2 * i] * rstd * nw[2 * i] * bflo(gu[i]), b = x[2 * i + 1] * rstd * nw[2 * i + 1] * bfhi(gu[i]); ou[i] = cvtpk(a, b); }
        bf16* op = OB + (row0 + er) * D + colo + eseg * 16;
        *(v4u*)op = (v4u){ou[0], ou[1], ou[2], ou[3]}; *(v4u*)(op + 8) = (v4u){ou[4], ou[5], ou[6], ou[7]};
    }
#pragma unroll
    for (int i = 0; i < 8; ++i) { const int p = 8 * dq + i, d = HG ? p : ((p >> 1) + 64 * (p & 1)); *(f32x4*)(s_out + (size_t)d * 128 + vcol) = (f32x4){S[i][0], S[i][1], S[i][2], S[i][3]}; }
}


__device__ __forceinline__ float dpp_rr_add(float x) {
    x += __builtin_bit_cast(float, __builtin_amdgcn_update_dpp(0, __builtin_bit_cast(int, x), 0x124, 0xf, 0xf, false));
    x += __builtin_bit_cast(float, __builtin_amdgcn_update_dpp(0, __builtin_bit_cast(int, x), 0x128, 0xf, 0xf, false));
    return x;
}
template <bool HG>
__device__ __forceinline__ void rec_units8(LAS unsigned char* lds, const bf16* proj, bf16* OB, const float* normw, const float* st, float* so, int u0, int ustep, int uend, int h, int tid) {
    const int w = __builtin_amdgcn_readfirstlane(tid >> 6), lane = tid & 63, dq = lane >> 2, vq = lane & 3;
    const int colq = (HG ? 2048 : 0) + 128 * h, colk = colq + 512, colv = colq + 1024, colg = colq + 1536, colo = (HG ? 512 : 0) + 128 * h;
    LAS bf16* Qs = (LAS bf16*)lds; LAS bf16* Ks = Qs + 64 * 128; LAS bf16* Vs = Ks + 64 * 128; LAS float* Os = (LAS float*)(lds + 49152);
    const int vcol = 16 * w + 4 * vq, pr = tid >> 4, pcn = tid & 15, er = tid >> 3, eseg = tid & 7;
    float nw[16];
#pragma unroll
    for (int i = 0; i < 16; ++i) nw[i] = normw[eseg * 16 + i];
    const float gam = exp2f(log2gamma(h));
    const v4u z4 = (v4u){0u, 0u, 0u, 0u};
    v4u tq = z4, tk = z4, tv = z4, g0 = z4, g1 = z4, nq = z4, nk = z4, nv = z4, n0 = z4, n1 = z4;
    f32x4 S4[8], N4[8];
#pragma unroll
    for (int i = 0; i < 8; ++i) { S4[i] = (f32x4){0.f, 0.f, 0.f, 0.f}; N4[i] = S4[i]; }
#define RU8_ISSUE(u_, TQ, TK, TV, G0, G1, SS) do { const int bs_ = (u_) >> 3; const size_t r0_ = (size_t)NP + (size_t)bs_ * 8; \
        if (tid < 128) { const bf16* src_ = proj + (r0_ + pr) * NIN + pcn * 8; TQ = *(const v4u*)(src_ + colq); TK = *(const v4u*)(src_ + colk); TV = *(const v4u*)(src_ + colv); } \
        if (tid < 64) { const bf16* gp_ = proj + (r0_ + er) * NIN + colg + eseg * 16; G0 = *(const v4u*)gp_; G1 = *(const v4u*)(gp_ + 8); } \
        const float* sin_ = st + (size_t)(bs_ * 4 + h) * 16384; \
        _Pragma("unroll") for (int i_ = 0; i_ < 8; ++i_) { const int p_ = 8 * dq + i_, d_ = HG ? p_ : ((p_ >> 1) + 64 * (p_ & 1)); SS[i_] = *(const f32x4*)(sin_ + (size_t)d_ * 128 + vcol); } } while (0)
    if (u0 < uend) RU8_ISSUE(u0, tq, tk, tv, g0, g1, S4);
    for (int u = u0; u < uend; u += ustep) {
        const int un = u + ustep, bs = u >> 3; const size_t row0 = (size_t)NP + (size_t)bs * 8;
        if (un < uend) RU8_ISSUE(un, nq, nk, nv, n0, n1, N4);
        __syncthreads();
        if (tid < 128) { *(LAS v4u*)(Qs + pr * 128 + pcn * 8) = tq; *(LAS v4u*)(Ks + pr * 128 + pcn * 8) = tk; *(LAS v4u*)(Vs + pr * 128 + pcn * 8) = tv; }
        __syncthreads();
#pragma unroll 2
        for (int t = 0; t < 8; ++t) {
            const v4u qu = *(const LAS v4u*)(Qs + t * 128 + 8 * dq), ku = *(const LAS v4u*)(Ks + t * 128 + 8 * dq); const v2u vu = *(const LAS v2u*)(Vs + t * 128 + vcol);
            float q[8], k[8], f[8], v[4];
            q[0] = bflo(qu.x); q[1] = bfhi(qu.x); q[2] = bflo(qu.y); q[3] = bfhi(qu.y); q[4] = bflo(qu.z); q[5] = bfhi(qu.z); q[6] = bflo(qu.w); q[7] = bfhi(qu.w);
            k[0] = bflo(ku.x); k[1] = bfhi(ku.x); k[2] = bflo(ku.y); k[3] = bfhi(ku.y); k[4] = bflo(ku.z); k[5] = bfhi(ku.z); k[6] = bflo(ku.w); k[7] = bfhi(ku.w);
            v[0] = bflo(vu.x); v[1] = bfhi(vu.x); v[2] = bflo(vu.y); v[3] = bfhi(vu.y);
            if (HG) {
#pragma unroll
                for (int i = 0; i < 8; ++i) { f[i] = __expf(k[i]); k[i] = 1.0f - f[i]; }
            } else {
#pragma unroll
                for (int i = 0; i < 8; ++i) f[i] = gam;
            }
            float o[4] = {0.f, 0.f, 0.f, 0.f};
#pragma unroll
            for (int i = 0; i < 8; ++i)
#pragma unroll
                for (int c = 0; c < 4; ++c) { S4[i][c] = f[i] * S4[i][c] + k[i] * v[c]; o[c] += q[i] * S4[i][c]; }
#pragma unroll
            for (int c = 0; c < 4; ++c) { o[c] = dpp_rr_add(o[c]); o[c] += __shfl_xor(o[c], 16); o[c] += __shfl_xor(o[c], 32); }
            if (dq == 0) *(LAS f32x4*)(Os + t * 128 + vcol) = (f32x4){o[0], o[1], o[2], o[3]};
        }
        __syncthreads();
        if (tid < 64) {
            float x[16]; float ssum = 0.f;
#pragma unroll
            for (int i = 0; i < 4; ++i) { const f32x4 t = *(const LAS f32x4*)(Os + er * 128 + eseg * 16 + 4 * i); x[4 * i] = t[0]; x[4 * i + 1] = t[1]; x[4 * i + 2] = t[2]; x[4 * i + 3] = t[3]; ssum += (t[0] * t[0] + t[1] * t[1]) + (t[2] * t[2] + t[3] * t[3]); }
            ssum += __shfl_xor(ssum, 1); ssum += __shfl_xor(ssum, 2); ssum += __shfl_xor(ssum, 4);
            const float rstd = rsqrtf(ssum * (1.0f / 128.0f) + EPS);
            const unsigned gu[8] = {g0.x, g0.y, g0.z, g0.w, g1.x, g1.y, g1.z, g1.w};
            unsigned ou[8];
#pragma unroll
            for (int i = 0; i < 8; ++i) { const float a = x[2 * i] * rstd * nw[2 * i] * bflo(gu[i]), b = x[2 * i + 1] * rstd * nw[2 * i + 1] * bfhi(gu[i]); ou[i] = cvtpk(a, b); }
            bf16* op = OB + (row0 + er) * D + colo + eseg * 16;
            *(v4u*)op = (v4u){ou[0], ou[1], ou[2], ou[3]}; *(v4u*)(op + 8) = (v4u){ou[4], ou[5], ou[6], ou[7]};
        }
        {   float* sout = so + (size_t)(bs * 4 + h) * 16384;
#pragma unroll
            for (int i = 0; i < 8; ++i) { const int p = 8 * dq + i, d = HG ? p : ((p >> 1) + 64 * (p & 1)); *(f32x4*)(sout + (size_t)d * 128 + vcol) = S4[i]; } }
        tq = nq; tk = nk; tv = nv; g0 = n0; g1 = n1;
#pragma unroll
        for (int i = 0; i < 8; ++i) S4[i] = N4[i];
    }
#undef RU8_ISSUE
}

typedef short bf16x8 __attribute__((ext_vector_type(8)));
constexpr int QS_STRIDE = 144, TS_STRIDE = 80, OS_STRIDE = 132;
constexpr int L_QS = 0, L_KS = 18432, L_KT = 36864, L_VT = 57344, L_PS = 77824, L_OS = 88064, L_ES = 121856, L_FS = 122368;
#define MFMA16(a, b, c) __builtin_amdgcn_mfma_f32_16x16x32_bf16((a), (b), (c), 0, 0, 0)
template <bool HG>
__device__ __forceinline__ void chunk_unit(LAS unsigned char* lds, const bf16* proj, const bf16* qkb, const int qks, bf16* OB, const float* normw, const float* ef, size_t row0, int nchunks, int h, float* s_out, const float* sl_base, const float* dl_base, int nseg, int tid) {
    const int w = __builtin_amdgcn_readfirstlane(tid >> 6), lane = tid & 63, n = lane & 15, g = lane >> 4;
    const int lr = 8 * w + g, lc = 8 * n;
    const int colq = 128 * h, colk = colq + 512, colv = (HG ? 2048 : 0) + 128 * h + 1024, colg = colv + 512, colo = (HG ? 512 : 0) + 128 * h;
    LAS bf16* Qs = (LAS bf16*)(lds + L_QS); LAS bf16* Ks = (LAS bf16*)(lds + L_KS); LAS bf16* Kt = (LAS bf16*)(lds + L_KT); LAS bf16* Vt = (LAS bf16*)(lds + L_VT);
    LAS bf16* Ps = (LAS bf16*)(lds + L_PS); LAS float* Os = (LAS float*)(lds + L_OS); LAS float* Es = (LAS float*)(lds + L_ES); LAS float* Fs = (LAS float*)(lds + L_FS);
    const float l2g = log2gamma(h);
    f32x4 S[8];
#pragma unroll
    for (int j = 0; j < 8; ++j) S[j] = (f32x4){0.f, 0.f, 0.f, 0.f};
    v4u rq[2], rk[2], rv[2], rg[2], nq[2], nk[2], nv[2], ng[2];
    f32x4 ref = (f32x4){0.f, 0.f, 0.f, 0.f}, nref = ref;
    {   const bf16* src = proj + (row0 + lr) * NIN + lc; const bf16* sqk = qkb + (row0 + lr) * qks + lc;
#pragma unroll
        for (int pc = 0; pc < 2; ++pc) { rq[pc] = *(const v4u*)(sqk + (size_t)(4 * pc) * qks + colq); rk[pc] = *(const v4u*)(sqk + (size_t)(4 * pc) * qks + colk); rv[pc] = *(const v4u*)(src + (size_t)(4 * pc) * NIN + colv);
            nq[pc] = *(const v4u*)(sqk + (size_t)(64 + 4 * pc) * qks + colq); nk[pc] = *(const v4u*)(sqk + (size_t)(64 + 4 * pc) * qks + colk); nv[pc] = *(const v4u*)(src + (size_t)(64 + 4 * pc) * NIN + colv); }
        if (HG) { if (tid < 64) { ref = *(const f32x4*)(ef + 4 * tid); nref = *(const f32x4*)(ef + 256 + 4 * tid); } } }
    {   const float g512 = exp2f(512.0f * l2g);
        for (int s2 = 0; s2 < nseg; ++s2) {
            const float* sp = sl_base + (size_t)s2 * 16384 + tid; const float* dp = dl_base + (size_t)s2 * 16384 + tid;
#pragma unroll
            for (int j = 0; j < 8; ++j)
#pragma unroll
                for (int i = 0; i < 4; ++i) { const float sv = sp[(j * 4 + i) * 512]; const float dv = HG ? dp[(j * 4 + i) * 512] : g512; S[j][i] = dv * S[j][i] + sv; }
        } }
    const int er = tid >> 3, eseg = tid & 7;
    { const bf16* gp = proj + (row0 + er) * NIN + colg + eseg * 16; rg[0] = *(const v4u*)gp; rg[1] = *(const v4u*)(gp + 8); }
    float nw[16];
#pragma unroll
    for (int i = 0; i < 16; ++i) nw[i] = normw[eseg * 16 + i];
    float rs[16];
#pragma unroll
    for (int i = 0; i < 16; ++i) rs[i] = HG ? 1.0f : exp2f((float)(16 * (i >> 2) + 4 * g + (i & 3) + 1) * l2g);
    const float f64 = exp2f(64.0f * l2g);
    for (int c = 0; c < nchunks; ++c) {
        const size_t crow = row0 + (size_t)c * 64;
#pragma unroll
        for (int pc = 0; pc < 2; ++pc) {
            const int r = lr + 4 * pc;
            *(LAS v4u*)(Qs + r * QS_STRIDE + lc) = rq[pc];
            *(LAS v4u*)(Ks + r * QS_STRIDE + lc) = rk[pc];
            const unsigned ku[4] = {rk[pc].x, rk[pc].y, rk[pc].z, rk[pc].w}, vu[4] = {rv[pc].x, rv[pc].y, rv[pc].z, rv[pc].w};
            const int tcol = ((w ^ (n & 7)) << 3) + g + 4 * pc;
#pragma unroll
            for (int i = 0; i < 8; ++i) { Kt[(lc + i) * TS_STRIDE + tcol] = (bf16)(ku[i >> 1] >> (16 * (i & 1))); Vt[(lc + i) * TS_STRIDE + tcol] = (bf16)(vu[i >> 1] >> (16 * (i & 1))); }
        }
        if (HG) { if (tid < 64) *(LAS f32x4*)(Es + 4 * tid) = ref; }
        __syncthreads();
        v4u fq[2], fk[2], fv[2]; f32x4 fref = (f32x4){0.f, 0.f, 0.f, 0.f};
#pragma unroll
        for (int pc = 0; pc < 2; ++pc) { fq[pc] = nq[pc]; fk[pc] = nk[pc]; fv[pc] = nv[pc]; }
        ng[0] = rg[0]; ng[1] = rg[1];
        if (c + 2 < nchunks) { const bf16* src = proj + (crow + 128 + lr) * NIN + lc; const bf16* sqk = qkb + (crow + 128 + lr) * qks + lc;
#pragma unroll
            for (int pc = 0; pc < 2; ++pc) { fq[pc] = *(const v4u*)(sqk + (size_t)(4 * pc) * qks + colq); fk[pc] = *(const v4u*)(sqk + (size_t)(4 * pc) * qks + colk); fv[pc] = *(const v4u*)(src + (size_t)(4 * pc) * NIN + colv); }
            if (HG) { if (tid < 64) fref = *(const f32x4*)(ef + (size_t)(c + 2) * 256 + 4 * tid); } }
        if (c + 1 < nchunks) { const bf16* gp = proj + (crow + 64 + er) * NIN + colg + eseg * 16; ng[0] = *(const v4u*)gp; ng[1] = *(const v4u*)(gp + 8); }
        {   const int I = w >> 1;
#pragma unroll
            for (int jj = 0; jj < 2; ++jj) {
                const int J = 2 * (w & 1) + jj;
                f32x4 a4 = (f32x4){0.f, 0.f, 0.f, 0.f};
                if (J <= I) {
#pragma unroll
                    for (int kk = 0; kk < 4; ++kk) {
                        const bf16x8 ka = *(const LAS bf16x8*)(Ks + (16 * J + n) * QS_STRIDE + 32 * kk + 8 * g);
                        const bf16x8 qb = *(const LAS bf16x8*)(Qs + (16 * I + n) * QS_STRIDE + 32 * kk + 8 * g);
                        a4 = MFMA16(ka, qb, a4);
                    }
                    if (J == I) {
#pragma unroll
                        for (int i = 0; i < 4; ++i) if (4 * g + i > n) a4[i] = 0.f;
                    }
                }
                *(LAS v2u*)(Ps + (16 * I + n) * TS_STRIDE + 16 * J + 4 * g) = (v2u){cvtpk(a4[0], a4[1]), cvtpk(a4[2], a4[3])};
            }
        }
        f32x4 O[4];
#pragma unroll
        for (int I = 0; I < 4; ++I) O[I] = (f32x4){0.f, 0.f, 0.f, 0.f};
        {
            if (HG) {
#pragma unroll
                for (int j = 0; j < 8; ++j) S[j] *= *(const LAS f32x4*)(Es + 16 * j + 4 * g);
            }
            bf16x8 sb[4];
#pragma unroll
            for (int kk = 0; kk < 4; ++kk) sb[kk] = __builtin_bit_cast(bf16x8, (v4u){cvtpk(S[2 * kk][0], S[2 * kk][1]), cvtpk(S[2 * kk][2], S[2 * kk][3]), cvtpk(S[2 * kk + 1][0], S[2 * kk + 1][1]), cvtpk(S[2 * kk + 1][2], S[2 * kk + 1][3])});
            __builtin_amdgcn_s_setprio(1);
#pragma unroll
            for (int I = 0; I < 4; ++I)
#pragma unroll
                for (int kk = 0; kk < 4; ++kk) {
                    const v2u lo = *(const LAS v2u*)(Qs + (16 * I + n) * QS_STRIDE + 32 * kk + 4 * g), hi = *(const LAS v2u*)(Qs + (16 * I + n) * QS_STRIDE + 32 * kk + 16 + 4 * g);
                    O[I] = MFMA16(__builtin_bit_cast(bf16x8, (v4u){lo.x, lo.y, hi.x, hi.y}), sb[kk], O[I]);
                }
            __builtin_amdgcn_s_setprio(0);
        }
        __syncthreads();
        {
            bf16x8 vb[2];
#pragma unroll
            for (int kk = 0; kk < 2; ++kk) vb[kk] = *(const LAS bf16x8*)(Vt + (16 * w + n) * TS_STRIDE + (((4 * kk + g) ^ ((2 * w + (n >> 3)) & 7)) << 3));
            __builtin_amdgcn_s_setprio(1);
#pragma unroll
            for (int I = 0; I < 4; ++I)
#pragma unroll
                for (int kk = 0; kk < 2; ++kk) O[I] = MFMA16(*(const LAS bf16x8*)(Ps + (16 * I + n) * TS_STRIDE + 32 * kk + 8 * g), vb[kk], O[I]);
#pragma unroll
            for (int j = 0; j < 8; ++j)
#pragma unroll
                for (int kk = 0; kk < 2; ++kk) S[j] = MFMA16(*(const LAS bf16x8*)(Kt + (16 * j + n) * TS_STRIDE + (((4 * kk + g) ^ ((2 * j + (n >> 3)) & 7)) << 3)), vb[kk], S[j]);
            __builtin_amdgcn_s_setprio(0);
            if (HG) {
#pragma unroll
                for (int j = 0; j < 8; ++j) S[j] *= *(const LAS f32x4*)(Fs + 16 * j + 4 * g);
            } else {
#pragma unroll
                for (int j = 0; j < 8; ++j) S[j] *= f64;
            }
        }
#pragma unroll
        for (int I = 0; I < 4; ++I)
#pragma unroll
            for (int i = 0; i < 4; ++i) { const int t = 16 * I + 4 * g + i; Os[t * OS_STRIDE + 16 * w + n] = HG ? O[I][i] : O[I][i] * rs[4 * I + i]; }
        __syncthreads();
        {
            float x[16]; float s = 0.f;
#pragma unroll
            for (int i = 0; i < 4; ++i) { const f32x4 t = *(const LAS f32x4*)(Os + er * OS_STRIDE + eseg * 16 + 4 * i); x[4 * i] = t[0]; x[4 * i + 1] = t[1]; x[4 * i + 2] = t[2]; x[4 * i + 3] = t[3]; s += (t[0] * t[0] + t[1] * t[1]) + (t[2] * t[2] + t[3] * t[3]); }
            s += __shfl_xor(s, 1); s += __shfl_xor(s, 2); s += __shfl_xor(s, 4);
            const float rstd = rsqrtf(s * (1.0f / 128.0f) + EPS);
            const unsigned gu[8] = {rg[0].x, rg[0].y, rg[0].z, rg[0].w, rg[1].x, rg[1].y, rg[1].z, rg[1].w};
            unsigned ou[8];
#pragma unroll
            for (int i = 0; i < 8; ++i) { const float a = x[2 * i] * rstd * nw[2 * i] * bflo(gu[i]), b = x[2 * i + 1] * rstd * nw[2 * i + 1] * bfhi(gu[i]); ou[i] = cvtpk(a, b); }
            bf16* op = OB + (crow + er) * D + colo + eseg * 16;
            *(v4u*)op = (v4u){ou[0], ou[1], ou[2], ou[3]}; *(v4u*)(op + 8) = (v4u){ou[4], ou[5], ou[6], ou[7]};
        }
#pragma unroll
        for (int pc = 0; pc < 2; ++pc) { rq[pc] = nq[pc]; rk[pc] = nk[pc]; rv[pc] = nv[pc]; nq[pc] = fq[pc]; nk[pc] = fk[pc]; nv[pc] = fv[pc]; }
        rg[0] = ng[0]; rg[1] = ng[1]; ref = nref; nref = fref;
    }
    if (s_out) {
#pragma unroll
    for (int j = 0; j < 8; ++j)
#pragma unroll
        for (int i = 0; i < 4; ++i) { const int p = 16 * j + 4 * g + i, d = HG ? p : ((p >> 1) + 64 * (p & 1)); __builtin_nontemporal_store(S[j][i], s_out + (size_t)d * 128 + 16 * w + n); }
    }
    __syncthreads();
}

template <bool HG>
__device__ __forceinline__ void state_unit(LAS unsigned char* lds, const bf16* proj, const bf16* qkb, const int qks, const float* ef, size_t row0, int nchunks, int h, float* sl_out, float* dl_out, int tid) {
    const int w = __builtin_amdgcn_readfirstlane(tid >> 6), lane = tid & 63, n = lane & 15, g = lane >> 4;
    const int lr = 8 * w + g, lc = 8 * n;
    const int colk = 128 * h + 512, colv = (HG ? 2048 : 0) + 128 * h + 1024;
    LAS bf16* Kt = (LAS bf16*)(lds + L_KT); LAS bf16* Vt = (LAS bf16*)(lds + L_VT); LAS float* Es = (LAS float*)(lds + L_ES); LAS float* Fs = (LAS float*)(lds + L_FS);
    const float f64 = exp2f(64.0f * log2gamma(h));
    f32x4 S[8], Dt[8];
#pragma unroll
    for (int j = 0; j < 8; ++j) { S[j] = (f32x4){0.f, 0.f, 0.f, 0.f}; Dt[j] = (f32x4){1.f, 1.f, 1.f, 1.f}; }
    v4u rk[2], rv[2], nk[2], nv[2]; f32x4 ref = (f32x4){0.f, 0.f, 0.f, 0.f}, nref = ref;
    {   const bf16* src = proj + (row0 + lr) * NIN + lc; const bf16* sqk = qkb + (row0 + lr) * qks + lc;
#pragma unroll
        for (int pc = 0; pc < 2; ++pc) { rk[pc] = *(const v4u*)(sqk + (size_t)(4 * pc) * qks + colk); rv[pc] = *(const v4u*)(src + (size_t)(4 * pc) * NIN + colv); }
        if (HG) { if (tid < 64) ref = *(const f32x4*)(ef + 4 * tid); } }
    for (int c = 0; c < nchunks; ++c) {
        const size_t crow = row0 + (size_t)c * 64;
#pragma unroll
        for (int pc = 0; pc < 2; ++pc) { nk[pc] = rk[pc]; nv[pc] = rv[pc]; }
        nref = ref;
        if (c + 1 < nchunks) { const bf16* src = proj + (crow + 64 + lr) * NIN + lc; const bf16* sqk = qkb + (crow + 64 + lr) * qks + lc;
#pragma unroll
            for (int pc = 0; pc < 2; ++pc) { nk[pc] = *(const v4u*)(sqk + (size_t)(4 * pc) * qks + colk); nv[pc] = *(const v4u*)(src + (size_t)(4 * pc) * NIN + colv); }
            if (HG) { if (tid < 64) nref = *(const f32x4*)(ef + (size_t)(c + 1) * 256 + 4 * tid); } }
#pragma unroll
        for (int pc = 0; pc < 2; ++pc) {
            const unsigned ku[4] = {rk[pc].x, rk[pc].y, rk[pc].z, rk[pc].w}, vu[4] = {rv[pc].x, rv[pc].y, rv[pc].z, rv[pc].w};
            const int tcol = ((w ^ (n & 7)) << 3) + g + 4 * pc;
#pragma unroll
            for (int i = 0; i < 8; ++i) { Kt[(lc + i) * TS_STRIDE + tcol] = (bf16)(ku[i >> 1] >> (16 * (i & 1))); Vt[(lc + i) * TS_STRIDE + tcol] = (bf16)(vu[i >> 1] >> (16 * (i & 1))); }
        }
        if (HG) { if (tid < 64) *(LAS f32x4*)(Es + 4 * tid) = ref; }
        __syncthreads();
        {
            if (HG) {
#pragma unroll
                for (int j = 0; j < 8; ++j) { const f32x4 e4 = *(const LAS f32x4*)(Es + 16 * j + 4 * g), f4 = *(const LAS f32x4*)(Fs + 16 * j + 4 * g); S[j] *= e4; Dt[j] *= e4 * f4; }
            }
            bf16x8 vb[2];
#pragma unroll
            for (int kk = 0; kk < 2; ++kk) vb[kk] = *(const LAS bf16x8*)(Vt + (16 * w + n) * TS_STRIDE + (((4 * kk + g) ^ ((2 * w + (n >> 3)) & 7)) << 3));
            __builtin_amdgcn_s_setprio(1);
#pragma unroll
            for (int j = 0; j < 8; ++j)
#pragma unroll
                for (int kk = 0; kk < 2; ++kk) S[j] = MFMA16(*(const LAS bf16x8*)(Kt + (16 * j + n) * TS_STRIDE + (((4 * kk + g) ^ ((2 * j + (n >> 3)) & 7)) << 3)), vb[kk], S[j]);
            __builtin_amdgcn_s_setprio(0);
            if (HG) {
#pragma unroll
                for (int j = 0; j < 8; ++j) S[j] *= *(const LAS f32x4*)(Fs + 16 * j + 4 * g);
            } else {
#pragma unroll
                for (int j = 0; j < 8; ++j) S[j] *= f64;
            }
        }
        __syncthreads();
#pragma unroll
        for (int pc = 0; pc < 2; ++pc) { rk[pc] = nk[pc]; rv[pc] = nv[pc]; }
        ref = nref;
    }
#pragma unroll
    for (int j = 0; j < 8; ++j)
#pragma unroll
        for (int i = 0; i < 4; ++i) { sl_out[(j * 4 + i) * 512 + tid] = S[j][i]; if (HG) dl_out[(j * 4 + i) * 512 + tid] = Dt[j][i]; }
}


constexpr int M8_QS = 0, M8_KS = 4608, M8_KT = 9216, M8_VT = 11264, M8_FS = 13312, M8_OS = 13824;
template <bool HG>
__device__ __forceinline__ void mf_units8(LAS unsigned char* lds, const bf16* proj, bf16* OB, const float* normw, const float* st, float* so, int u0, int ustep, int uend, int h, int tid) {
    const int w = __builtin_amdgcn_readfirstlane(tid >> 6), lane = tid & 63, n = lane & 15, g = lane >> 4;
    const int colq = (HG ? 2048 : 0) + 128 * h, colk = colq + 512, colv = colq + 1024, colg = colq + 1536, colo = (HG ? 512 : 0) + 128 * h;
    LAS bf16* Qs = (LAS bf16*)(lds + M8_QS); LAS bf16* Ks = (LAS bf16*)(lds + M8_KS); LAS bf16* Kt = (LAS bf16*)(lds + M8_KT); LAS bf16* Vt = (LAS bf16*)(lds + M8_VT);
    LAS float* Fs = (LAS float*)(lds + M8_FS); LAS float* Os = (LAS float*)(lds + M8_OS);
    const int er = tid >> 3, eseg = tid & 7;
    const int tr = lane >> 3, tc = lane & 7;
    const float l2g = log2gamma(h);
    float nw[16];
#pragma unroll
    for (int i = 0; i < 16; ++i) nw[i] = normw[eseg * 16 + i];
    __syncthreads();
    for (int i = tid; i < 2 * 8 * 144 / 2; i += NTHR) { ((LAS unsigned*)(Qs + 8 * 144))[i % (8 * 144 / 2)] = 0u; ((LAS unsigned*)(Ks + 8 * 144))[i % (8 * 144 / 2)] = 0u; }
    for (int u = u0; u < uend; u += ustep) {
        const int bs = u >> 3; const size_t row0 = (size_t)NP + (size_t)bs * 8;
        const float* sin = st + (size_t)(bs * 4 + h) * 16384; float* sout = so + (size_t)(bs * 4 + h) * 16384;
        v4u tq[2], tk[2], tv[2], g0 = (v4u){0u, 0u, 0u, 0u}, g1 = g0;
#pragma unroll
        for (int pc = 0; pc < 2; ++pc) { tq[pc] = g0; tk[pc] = g0; tv[pc] = g0; }
        if (w == 0) {
            const bf16* src = proj + (row0 + tr) * NIN + 8 * tc;
#pragma unroll
            for (int pc = 0; pc < 2; ++pc) { tq[pc] = *(const v4u*)(src + colq + 64 * pc); tk[pc] = *(const v4u*)(src + colk + 64 * pc); tv[pc] = *(const v4u*)(src + colv + 64 * pc); }
            const bf16* gp = proj + (row0 + er) * NIN + colg + eseg * 16; g0 = *(const v4u*)gp; g1 = *(const v4u*)(gp + 8);
        }
        f32x4 S[8];
#pragma unroll
        for (int j = 0; j < 8; ++j)
#pragma unroll
            for (int i = 0; i < 4; ++i) { const int p = 16 * j + 4 * g + i, d = HG ? p : ((p >> 1) + 64 * (p & 1)); S[j][i] = __builtin_nontemporal_load(sin + (size_t)d * 128 + 16 * w + n); }
        __syncthreads();
        if (w == 0) {
#pragma unroll
            for (int pc = 0; pc < 2; ++pc) {
                const int cc = tc + 8 * pc;
                const unsigned qu[4] = {tq[pc].x, tq[pc].y, tq[pc].z, tq[pc].w}, ku[4] = {tk[pc].x, tk[pc].y, tk[pc].z, tk[pc].w};
                float qp[8], kp[8];
#pragma unroll
                for (int i = 0; i < 8; ++i) {
                    const float q = (i & 1) ? bfhi(qu[i >> 1]) : bflo(qu[i >> 1]), kx = (i & 1) ? bfhi(ku[i >> 1]) : bflo(ku[i >> 1]);
                    if (HG) {
                        float b = kx;
                        { const float t1 = __shfl_up(b, 8); if (lane >= 8) b += t1; const float t2 = __shfl_up(b, 16); if (lane >= 16) b += t2; const float t3 = __shfl_up(b, 32); if (lane >= 32) b += t3; }
                        const float b7 = __shfl(b, 56 + tc);
                        qp[i] = q * __expf(b); kp[i] = (1.0f - __expf(kx)) * __expf(fminf(-b, 80.f));
                        if (tr == 7) Fs[8 * cc + i] = __expf(b7);
                    } else { qp[i] = q; kp[i] = kx * exp2f(-(float)(tr + 1) * l2g); }
                }
                const v4u qo = (v4u){cvtpk(qp[0], qp[1]), cvtpk(qp[2], qp[3]), cvtpk(qp[4], qp[5]), cvtpk(qp[6], qp[7])};
                const v4u ko = (v4u){cvtpk(kp[0], kp[1]), cvtpk(kp[2], kp[3]), cvtpk(kp[4], kp[5]), cvtpk(kp[6], kp[7])};
                *(LAS v4u*)(Qs + tr * 144 + 8 * cc) = qo; *(LAS v4u*)(Ks + tr * 144 + 8 * cc) = ko;
                const unsigned kw[4] = {ko.x, ko.y, ko.z, ko.w}, vw[4] = {tv[pc].x, tv[pc].y, tv[pc].z, tv[pc].w};
#pragma unroll
                for (int i = 0; i < 8; ++i) { Kt[(8 * cc + i) * 8 + tr] = (bf16)(kw[i >> 1] >> (16 * (i & 1))); Vt[(8 * cc + i) * 8 + tr] = (bf16)(vw[i >> 1] >> (16 * (i & 1))); }
            }
        }
        __syncthreads();
        f32x4 a4 = (f32x4){0.f, 0.f, 0.f, 0.f};
#pragma unroll
        for (int kk = 0; kk < 4; ++kk) a4 = MFMA16(*(const LAS bf16x8*)(Ks + n * 144 + 32 * kk + 8 * g), *(const LAS bf16x8*)(Qs + n * 144 + 32 * kk + 8 * g), a4);
#pragma unroll
        for (int i = 0; i < 4; ++i) if (4 * g + i > n) a4[i] = 0.f;
        const bf16x8 pa = __builtin_bit_cast(bf16x8, (v4u){cvtpk(a4[0], a4[1]), cvtpk(a4[2], a4[3]), 0u, 0u});
        v2u vraw = (v2u){0u, 0u};
        if (g < 2) vraw = *(const LAS v2u*)(Vt + (16 * w + n) * 8 + 4 * g);
        const bf16x8 vb = __builtin_bit_cast(bf16x8, (v4u){vraw.x, vraw.y, 0u, 0u});
        f32x4 O = MFMA16(pa, vb, ((f32x4){0.f, 0.f, 0.f, 0.f}));
#pragma unroll
        for (int kk = 0; kk < 4; ++kk) {
            const bf16x8 sb = __builtin_bit_cast(bf16x8, (v4u){cvtpk(S[2 * kk][0], S[2 * kk][1]), cvtpk(S[2 * kk][2], S[2 * kk][3]), cvtpk(S[2 * kk + 1][0], S[2 * kk + 1][1]), cvtpk(S[2 * kk + 1][2], S[2 * kk + 1][3])});
            const v2u lo = *(const LAS v2u*)(Qs + n * 144 + 32 * kk + 4 * g), hi = *(const LAS v2u*)(Qs + n * 144 + 32 * kk + 16 + 4 * g);
            O = MFMA16(__builtin_bit_cast(bf16x8, (v4u){lo.x, lo.y, hi.x, hi.y}), sb, O);
        }
#pragma unroll
        for (int j = 0; j < 8; ++j) {
            v2u kraw = (v2u){0u, 0u};
            if (g < 2) kraw = *(const LAS v2u*)(Kt + (16 * j + n) * 8 + 4 * g);
            S[j] = MFMA16(__builtin_bit_cast(bf16x8, (v4u){kraw.x, kraw.y, 0u, 0u}), vb, S[j]);
            if (HG) S[j] *= *(const LAS f32x4*)(Fs + 16 * j + 4 * g); else S[j] *= exp2f(8.0f * l2g);
        }
        if (g < 2) {
#pragma unroll
            for (int i = 0; i < 4; ++i) { const int t = 4 * g + i; Os[t * OS_STRIDE + 16 * w + n] = HG ? O[i] : O[i] * exp2f((float)(t + 1) * l2g); }
        }
        __syncthreads();
        if (tid < 64) {
            float x[16]; float ssum = 0.f;
#pragma unroll
            for (int i = 0; i < 4; ++i) { const f32x4 t = *(const LAS f32x4*)(Os + er * OS_STRIDE + eseg * 16 + 4 * i); x[4 * i] = t[0]; x[4 * i + 1] = t[1]; x[4 * i + 2] = t[2]; x[4 * i + 3] = t[3]; ssum += (t[0] * t[0] + t[1] * t[1]) + (t[2] * t[2] + t[3] * t[3]); }
            ssum += __shfl_xor(ssum, 1); ssum += __shfl_xor(ssum, 2); ssum += __shfl_xor(ssum, 4);
            const float rstd = rsqrtf(ssum * (1.0f / 128.0f) + EPS);
            const unsigned gu[8] = {g0.x, g0.y, g0.z, g0.w, g1.x, g1.y, g1.z, g1.w};
            unsigned ou[8];
#pragma unroll
            for (int i = 0; i < 8; ++i) { const float a = x[2 * i] * rstd * nw[2 * i] * bflo(gu[i]), b = x[2 * i + 1] * rstd * nw[2 * i + 1] * bfhi(gu[i]); ou[i] = cvtpk(a, b); }
            bf16* op = OB + (row0 + er) * D + colo + eseg * 16;
            *(v4u*)op = (v4u){ou[0], ou[1], ou[2], ou[3]}; *(v4u*)(op + 8) = (v4u){ou[4], ou[5], ou[6], ou[7]};
        }
#pragma unroll
        for (int j = 0; j < 8; ++j)
#pragma unroll
            for (int i = 0; i < 4; ++i) { const int p = 16 * j + 4 * g + i, d = HG ? p : ((p >> 1) + 64 * (p & 1)); __builtin_nontemporal_store(S[j][i], sout + (size_t)d * 128 + 16 * w + n); }
    }
    __syncthreads();
}

#define XB_TMO      128
#define XB_XCNT(j)  (256  + 64 * (j))
#define XB_XSUB(j)  (1280 + 64 * (j))
#define XB_XGEN(j)  (2304 + 64 * (j))
#define XB_TOP      3328
#define XB_TOPGEN   3392
#define XCD_BAR_WORDS 3456
#define XB_SPIN_CAP (1u << 18)

__device__ __forceinline__ unsigned xb_ld(unsigned* p)              { return __hip_atomic_load(p, __ATOMIC_RELAXED, __HIP_MEMORY_SCOPE_AGENT); }
__device__ __forceinline__ unsigned xb_add(unsigned* p, unsigned v) { return __hip_atomic_fetch_add(p, v, __ATOMIC_RELAXED, __HIP_MEMORY_SCOPE_AGENT); }
__device__ __forceinline__ unsigned xb_xcc_id() { return (unsigned)__builtin_amdgcn_s_getreg((3 << 11) | 20) & 0xFu; }
#define XB_SPIN(cond, bar) do { unsigned _sp = 0; while (cond) { __builtin_amdgcn_s_sleep(1); \
    if ((++_sp & 255u) == 0u) { if (xb_ld(&(bar)[XB_TMO])) break; if (_sp > XB_SPIN_CAP) { atomicAdd(&(bar)[XB_TMO], 1u); break; } } } } while (0)

struct XcdBarrier {
    unsigned* bar; unsigned x;
    volatile LAS unsigned* st;
};

__device__ __forceinline__ XcdBarrier xcd_barrier_post(unsigned* bar, volatile LAS unsigned* st) {
    XcdBarrier b; b.bar = bar; b.x = xb_xcc_id(); b.st = st;
    if (threadIdx.x == 0) (void)xb_add(&bar[XB_XCNT(b.x)], 1u);
    return b;
}
__device__ __forceinline__ void xcd_barrier_complete(unsigned* bar, unsigned x, unsigned& nloc, unsigned& nx) {
    const unsigned G = gridDim.x * gridDim.y * gridDim.z;
    unsigned sum, cnt, mine, sp = 0u;
    for (;;) {
        sum = 0u; cnt = 0u; mine = 0u;
#pragma unroll
        for (unsigned j = 0; j < 16; ++j) { const unsigned c = xb_ld(&bar[XB_XCNT(j)]); sum += c; cnt += (c > 0u) ? 1u : 0u; mine = (j == x) ? c : mine; }
        if (sum == G) break;
        __builtin_amdgcn_s_sleep(1);
        if ((++sp & 255u) == 0u) { if (xb_ld(&bar[XB_TMO])) break; if (sp > XB_SPIN_CAP) { atomicAdd(&bar[XB_TMO], 1u); break; } }
    }
    nloc = mine > 0u ? mine : 1u; nx = cnt > 0u ? cnt : 1u;
}

__device__ __forceinline__ void xcd_barrier(const XcdBarrier& b) {
    asm volatile("s_waitcnt vmcnt(0)" ::: "memory");
    __syncthreads();
    if (threadIdx.x == 0) {
        unsigned* bar = b.bar;
        __builtin_amdgcn_s_waitcnt(0);
        unsigned nloc = b.st[0], nx = b.st[1];
        if (nloc == 0u) { xcd_barrier_complete(bar, b.x, nloc, nx); b.st[0] = nloc; b.st[1] = nx; }
        const unsigned old = xb_add(&bar[XB_XSUB(b.x)], 1u);
        const unsigned gen = old / nloc;
        if (old + 1u == (gen + 1u) * nloc) {
            __builtin_amdgcn_fence(__ATOMIC_RELEASE, "agent");
            asm volatile("s_waitcnt vmcnt(0)" ::: "memory");
            const unsigned og = xb_add(&bar[XB_TOP], 1u);
            const unsigned tg = og / nx;
            if (og + 1u == (tg + 1u) * nx) xb_add(&bar[XB_TOPGEN], 1u);
            else XB_SPIN(xb_ld(&bar[XB_TOPGEN]) == tg, bar);
            __builtin_amdgcn_fence(__ATOMIC_ACQUIRE, "agent");
            xb_add(&bar[XB_XGEN(b.x)], 1u);
            asm volatile("s_waitcnt vmcnt(0)" ::: "memory");
        } else {
            XB_SPIN(xb_ld(&bar[XB_XGEN(b.x)]) == gen, bar);
            __builtin_amdgcn_fence(__ATOMIC_ACQUIRE, "agent");
            asm volatile("s_waitcnt vmcnt(0)" ::: "memory");
        }
    }
    __syncthreads();
}

__device__ __forceinline__ void grid_seam(cg::grid_group& grid) {
#if defined(SEAM_HARD)
    __builtin_amdgcn_fence(__ATOMIC_RELEASE, "agent");
    asm volatile("s_waitcnt vmcnt(0)" ::: "memory");
#endif
    grid.sync();
#if defined(SEAM_HARD)
    __builtin_amdgcn_fence(__ATOMIC_ACQUIRE, "agent");
    asm volatile("s_waitcnt vmcnt(0)" ::: "memory");
#endif
}
struct Args { const float* in[14]; float* out; unsigned char* ws; int ph_lo, ph_hi, rep2, rep3; };
__global__ void __launch_bounds__(NTHR, 2) mega_fwd(Args a) {
    extern __shared__ __attribute__((aligned(16))) unsigned char lds_raw[];
    LAS unsigned char* lds = (LAS unsigned char*)lds_raw;
    cg::grid_group grid = cg::this_grid();
    const int wave = __builtin_amdgcn_readfirstlane((int)threadIdx.x >> 6);
#define lane ((int)__builtin_amdgcn_mbcnt_hi(~0u, __builtin_amdgcn_mbcnt_lo(~0u, 0u)))
#define tid (wave * 64 + lane)
    const int G = gridDim.x, bx = blockIdx.x;
    const float* x_p = a.in[0]; const float* x_s = a.in[1]; const float* st_ret = a.in[2]; const float* st_hg = a.in[3];
    const float* norm_mix_w = a.in[4]; const float* w_in = a.in[5]; const float* ret_norm_w = a.in[6]; const float* hg_norm_w = a.in[7];
    const float* lb_logits = a.in[8]; const float* w_out = a.in[9]; const float* norm_ffn_w = a.in[10]; const float* w_up = a.in[11]; const float* w_down = a.in[12];
    const float* final_norm_w = a.in[13];
    unsigned char* ws = a.ws; float* out = a.out;
    bf16* WinT = (bf16*)(ws + WS_WIN); bf16* WoutT = (bf16*)(ws + WS_WOUT); bf16* WupT = (bf16*)(ws + WS_WUP); bf16* WdnT = (bf16*)(ws + WS_WDN);
    float* tab = (float*)(ws + WS_TAB); float* ssq = (float*)(ws + WS_SSQ); float* EF = (float*)(ws + WS_EF); float* r2v = (float*)(ws + WS_SSQ + (size_t)M * 16 * 4 + 4096);
    float* SL = out + OUT_Y + (size_t)8 * 1024 * 1024;
    float* DL = SL + (size_t)64 * 3 * 16384;
    bf16* QKP = (bf16*)(out + OUT_Y);
    bf16* XN = (bf16*)(ws + WS_XN); bf16* PROJ = (bf16*)(ws + WS_PROJ); bf16* HB = (bf16*)(ws + WS_PROJ); bf16* OB = (bf16*)(ws + WS_OB);
    volatile LAS unsigned* xst = (volatile LAS unsigned*)(lds + 131072);
    if ((int)threadIdx.x < 16) xst[threadIdx.x] = 0u;
    __syncthreads();
    const XcdBarrier xbar = xcd_barrier_post((unsigned*)(ws + WS_CTL), xst);
    const int lo = a.ph_lo, hi = a.ph_hi;
#define IN(k) (lo <= (k) && (k) < hi)
#define SEAM(k) do { if (IN(k) && IN((k) + 1)) { if ((k) == 0) grid_seam(grid); else xcd_barrier(xbar); } } while (0)

    if (IN(0)) {
        LAS float* scr = (LAS float*)(lds + wave * 16384);
        const int gw = bx * NWAVES + wave, NGW = G * NWAVES;
        constexpr int I_IN = (D / 64) * (NIN / 32);
        for (int it = gw; it < I_IN; it += NGW) p0_transpose_item<true>(w_in, D, NIN, WinT, nullptr, scr, it, lane);
        for (int m = gw; m < M; m += NGW) rms_row_to_bf16(m < NP ? x_p + (size_t)m * D : x_s + (size_t)(m - NP) * D, norm_mix_w, XN + (size_t)m * D, lane);
        for (int i = bx * NTHR + tid; i < (TP + 8) * 64; i += G * NTHR) {
            const int pi = i >> 6, j = i & 63; const double pos = (double)(pi < TP ? pi : 16384 + (pi - TP));
            double t = pos * INVF[j] * 0.15915494309189535; t -= __builtin_rint(t);
            tab[2 * i] = __builtin_amdgcn_cosf((float)t); tab[2 * i + 1] = __builtin_amdgcn_sinf((float)t);
        }
    }
    SEAM(0);
    if (IN(1)) for (int rep = 0; rep < NREP(1); ++rep) { if (rep) grid_seam(grid);
        pg8::Gemm g{XN, WinT, M, NIN, D}; pg8::StaticOrder S; S.init(M, NIN, G, bx, D);
        unsigned* hcnt = (unsigned*)(ws + WS_CTL) + 8192;
        EpiProj E{PROJ, tab, lb_logits, hcnt};
        pg8::gemm_phase<EpiProj, pg8::StaticOrder, true, true>(lds, g, S, E, tid);
        {
            constexpr int NFULL = ((M / 256) * (NIN / 256)) % 256;
            if (bx >= NFULL) {
                LAS float* scr = (LAS float*)(lds + wave * 16384);
                constexpr int I_OUT = (D / 64) * (D / 32);
                for (int it = (bx - NFULL) * NWAVES + wave; it < I_OUT; it += (G - NFULL) * NWAVES) p0_transpose_item<false>(w_out, D, D, WoutT, nullptr, scr, it, lane);
                if (threadIdx.x == 0) {
                    unsigned sp = 0u;
                    while (__hip_atomic_load(hcnt, __ATOMIC_RELAXED, __HIP_MEMORY_SCOPE_AGENT) < 256u) { __builtin_amdgcn_s_sleep(2); if (++sp > (1u << 22)) break; }
                    __builtin_amdgcn_fence(__ATOMIC_ACQUIRE, "agent");
                    asm volatile("s_waitcnt vmcnt(0)" ::: "memory");
                }
                __syncthreads();
                for (int bi = bx - NFULL; bi < 8 * 4 * 32; bi += G - NFULL) hg_prep_item2(PROJ, QKP, EF, bi * 16 + wave, bi * 16 + wave + 8, lane);
            }
        }
    }
    SEAM(1);
    if (IN(2)) {
        if (bx < 192) {
            const int stream = bx / 3, seg = bx - 3 * stream, b = stream >> 3, hd = stream & 7; const size_t row0 = (size_t)b * TP + (size_t)seg * 512;
            if (hd < 4) state_unit<false>(lds, PROJ, PROJ, NIN, nullptr, row0, 8, hd, SL + (size_t)(stream * 3 + seg) * 16384, nullptr, tid);
            else state_unit<true>(lds, PROJ, QKP, 1024, EF + ((size_t)(b * 4 + hd - 4) * 32 + seg * 8) * 256, row0, 8, hd - 4, SL + (size_t)(stream * 3 + seg) * 16384, DL + (size_t)((b * 4 + hd - 4) * 3 + seg) * 16384, tid);
            {
                const int u = 128 + bx, hs = u & 7;
                if (hs < 4) mf_units8<false>(lds, PROJ, OB, ret_norm_w, st_ret, out + OUT_RSS, u, 1024, 1024, hs, tid);
                else mf_units8<true>(lds, PROJ, OB, hg_norm_w, st_hg, out + OUT_HSS, u, 1024, 1024, hs - 4, tid);
            }
        } else {
            const int u0 = bx - 192, hs = u0 & 7;
            if (hs < 4) mf_units8<false>(lds, PROJ, OB, ret_norm_w, st_ret, out + OUT_RSS, u0, 64, 128, hs, tid);
            else mf_units8<true>(lds, PROJ, OB, hg_norm_w, st_hg, out + OUT_HSS, u0, 64, 128, hs - 4, tid);
        }
        xcd_barrier(xbar);
        {
            const int stream = bx >> 2, seg = bx & 3, b = stream >> 3, hd = stream & 7; const size_t row0 = (size_t)b * TP + (size_t)seg * 512;
            if (hd < 4) chunk_unit<false>(lds, PROJ, PROJ, NIN, OB, ret_norm_w, nullptr, row0, 8, hd, seg == 3 ? out + OUT_RSP + (size_t)(b * 4 + hd) * 16384 : nullptr, SL + (size_t)(stream * 3) * 16384, nullptr, seg, tid);
            else chunk_unit<true>(lds, PROJ, QKP, 1024, OB, hg_norm_w, EF + ((size_t)(b * 4 + hd - 4) * 32 + seg * 8) * 256, row0, 8, hd - 4, seg == 3 ? out + OUT_HSP + (size_t)(b * 4 + hd - 4) * 16384 : nullptr, SL + (size_t)(stream * 3) * 16384, DL + (size_t)((b * 4 + hd - 4) * 3) * 16384, seg, tid);
            {   const int u0 = 320 + (bx & 3) * 64 + (bx >> 2), hs = u0 & 7;
                if (hs < 4) mf_units8<false>(lds, PROJ, OB, ret_norm_w, st_ret, out + OUT_RSS, u0, 256, 1024, hs, tid);
                else mf_units8<true>(lds, PROJ, OB, hg_norm_w, st_hg, out + OUT_HSS, u0, 256, 1024, hs - 4, tid);
            }
        }
    }
    SEAM(2);
    if (IN(3)) for (int rep = 0; rep < NREP(3); ++rep) { if (rep) grid_seam(grid);
        pg8::Gemm g{OB, WoutT, M, D, D}; OutOrder S; S.init(G, bx);
        EpiOut E{x_p, x_s, out + OUT_Y, XN, ssq, (float*)(ws + WS_PROJ)};
        pg8::gemm_phase<EpiOut, OutOrder, true, true>(lds, g, S, E, tid);
        if (bx >= 16 * OUT_SPLIT) {
            LAS float* scr = (LAS float*)(lds + wave * 16384);
            constexpr int I_UP = (D / 64) * (FF / 32);
            for (int it = (bx - 16 * OUT_SPLIT) * NWAVES + wave; it < I_UP; it += (G - 16 * OUT_SPLIT) * NWAVES) p0_transpose_item<false>(w_up, D, FF, WupT, norm_ffn_w, scr, it, lane);
        }
    }
    SEAM(3);
    if (IN(4)) for (int rep = 0; rep < NREP(4); ++rep) { if (rep) grid_seam(grid);
        {
            const int gw = bx * NWAVES + wave, NGW = G * NWAVES;
            for (int m = gw; m < NS; m += NGW) sample_out_reduce(x_s + (size_t)m * D, (const float*)(ws + WS_PROJ) + (size_t)m * D, out + OUT_Y + (size_t)(NP + m) * D, XN + (size_t)(NP + m) * D, r2v + NP + m, lane);
            for (int r = bx * NTHR + tid; r < NP; r += G * NTHR) {
                const f32x4* sp = (const f32x4*)(ssq + (size_t)r * 16); const f32x4 a4 = sp[0], b4 = sp[1], c4 = sp[2], d4 = sp[3];
                const float ss = ((a4[0] + a4[1]) + (a4[2] + a4[3])) + ((b4[0] + b4[1]) + (b4[2] + b4[3])) + ((c4[0] + c4[1]) + (c4[2] + c4[3])) + ((d4[0] + d4[1]) + (d4[2] + d4[3]));
                r2v[r] = 1.0f / (ss * (1.0f / D) + EPS);
            }
            xcd_barrier(xbar);
        }
        pg8::Gemm g{XN, WupT, M, FF, D}; pg8::StaticOrder S; S.init(M, FF, G, bx, D);
        EpiUp E{HB, r2v};
        pg8::gemm_phase<EpiUp, pg8::StaticOrder, true, true>(lds, g, S, E, tid);
        {   constexpr int NFULL4 = ((M / 256) * (FF / 256)) % 256;
            if (bx >= NFULL4) {
                LAS float* scr = (LAS float*)(lds + wave * 16384);
                constexpr int I_DN = (FF / 64) * (D / 32);
                for (int it = (bx - NFULL4) * NWAVES + wave; it < I_DN; it += (G - NFULL4) * NWAVES) p0_transpose_item<false>(w_down, FF, D, WdnT, nullptr, scr, it, lane);
            }
        }
    }
    SEAM(4);
    if (IN(5)) {
        pg8::Gemm g{HB, WdnT, M, D, FF}; DownOrder S; S.init(G, bx);
        EpiDown E{XN, (float*)(ws + WS_OB)};
        pg8::gemm_phase<EpiDown, DownOrder, true, true>(lds, g, S, E, tid);
    }
    SEAM(5);
    if (IN(6)) {
        const int gw = bx * NWAVES + wave, NGW = G * NWAVES;
        for (int m = gw; m < NP; m += 2 * NGW) { const int m2 = m + NGW;
            rms_row2_from_bf16(XN + (size_t)m * D, out + OUT_Y + (size_t)m * D, m2 < NP ? XN + (size_t)m2 * D : nullptr, out + OUT_Y + (size_t)(m2 < NP ? m2 : m) * D, final_norm_w, lane); }
        for (int m = NP + gw; m < M; m += NGW) rms_row_inplace(out + OUT_Y + (size_t)m * D, final_norm_w, lane, (const float*)(ws + WS_OB) + (size_t)(m - NP) * D);
    }
#undef IN
#undef SEAM
#undef lane
#undef tid
}

extern "C" void kernel_launch(void* const* d_in, const int* in_sizes, int n_in, void* d_out, int out_size, void* d_ws, size_t ws_size, hipStream_t stream) {
    static int grid = 0;
    if (grid == 0) {
        if (n_in != 14 || in_sizes[0] != NP * D || ws_size < WS_END) { fprintf(stderr, "kernel_launch: unexpected shapes (n_in %d, in0 %d, ws %zu)\n", n_in, n_in > 0 ? in_sizes[0] : -1, ws_size); grid = -1; return; }
        int dev = 0, cus = 0, per_cu = 0;
        if (hipGetDevice(&dev) != hipSuccess || hipDeviceGetAttribute(&cus, hipDeviceAttributeMultiprocessorCount, dev) != hipSuccess) { grid = -1; return; }
        if (hipFuncSetAttribute((const void*)mega_fwd, hipFuncAttributeMaxDynamicSharedMemorySize, LDS_BYTES) != hipSuccess) { fprintf(stderr, "kernel_launch: hipFuncSetAttribute failed\n"); grid = -1; return; }
        if (hipOccupancyMaxActiveBlocksPerMultiprocessor(&per_cu, (const void*)mega_fwd, NTHR, LDS_BYTES) != hipSuccess || per_cu < 1) { fprintf(stderr, "kernel_launch: occupancy query says %d blocks per CU\n", per_cu); (void)hipGetLastError(); grid = -1; return; }
        grid = 256;
        if (cus * per_cu < 256) { fprintf(stderr, "kernel_launch: needs 256 co-resident workgroups; the device holds %d\n", cus * per_cu); grid = -1; return; }
    }
    if (grid < 0) return;
    if (hipMemsetAsync((char*)d_ws + WS_CTL, 0, CTL_BYTES, stream) != hipSuccess) { fprintf(stderr, "kernel_launch: memset of the barrier words failed\n"); return; }
    Args a{};
    for (int i = 0; i < 14; ++i) a.in[i] = (const float*)d_in[i];
    a.out = (float*)d_out; a.ws = (unsigned char*)d_ws;
#ifndef PROBE_REP2
#define PROBE_REP2 1
#endif
#ifndef PROBE_REP3
#define PROBE_REP3 1
#endif
    a.ph_lo = 0; a.ph_hi = N_PHASES; a.rep2 = PROBE_REP2; a.rep3 = PROBE_REP3;
    void* args[] = {&a};
    hipError_t e = hipLaunchCooperativeKernel((const void*)mega_fwd, dim3(grid), dim3(NTHR), args, LDS_BYTES, stream);
    if (e != hipSuccess) fprintf(stderr, "cooperative launch failed: %s (grid %d)\n", hipGetErrorString(e), grid);
}
```

```cpp
#include <hip/hip_runtime.h>
#include <hip/hip_cooperative_groups.h>
#include <cstdio>
#include <cstdint>
namespace cg = cooperative_groups;
namespace pg8 {
#define PG8_LAS __attribute__((address_space(3)))
typedef unsigned short bf16_t;
typedef short bf16x8 __attribute__((ext_vector_type(8)));
typedef float f32x4 __attribute__((ext_vector_type(4)));
typedef unsigned u32x4 __attribute__((ext_vector_type(4)));
constexpr int BM = 256, BK = 64, HALF = 128, HTB = HALF * BK * 2  , STAGE_BYTES = 8 * HTB, NXCD = 8, WGM = 8;

__host__ __device__ __forceinline__ int lds_byte(int r, int c) { const int st = (r >> 4) * 2 + (c >> 5), rr = r & 15, cc = c & 31, ob = rr * 64 + cc * 2; return st * 1024 + (ob ^ (((ob >> 9) & 1) << 5)); }
__host__ __device__ __forceinline__ void stage_rc(int b, int& R, int& C) { const int st = b / 1024, sb = b % 1024, swz = sb ^ (((sb >> 9) & 1) << 5); R = (st >> 1) * 16 + swz / 64; C = (st & 1) * 32 + (swz % 64) / 2; }
__host__ __device__ __forceinline__ int perm32(int rho) { const int n = rho >> 4, i = rho & 15; return 8 * (i >> 2) + 4 * n + (i & 3); }

struct Unit { int pm, pn, k0, nt; };
struct Gemm { const bf16_t* A; const bf16_t* Bt; int M, N, K; };

struct StaticOrder {
    int nM, nN, nwg, G, c, ntk;
    __host__ __device__ void init(int M, int N, int G_, int c_, int K_) { nM = M / BM; nN = N / BM; nwg = nM * nN; G = G_; c = c_; ntk = K_ / BK; }
    __host__ __device__ bool next(int i, Unit& u) const {
        const long L = (long)i * G + c; if (L >= nwg) return false;
        int wgid = (int)L; { const int q = nwg / NXCD, r = nwg % NXCD, xcd = wgid % NXCD, off = wgid / NXCD; wgid = (xcd < r ? xcd * (q + 1) : r * (q + 1) + (xcd - r) * q) + off; }
        const int nig = WGM * nN, gid = wgid / nig, fm = gid * WGM, gsz = (nM - fm) < WGM ? (nM - fm) : WGM;
        u.pm = fm + ((wgid % nig) % gsz); u.pn = (wgid % nig) / gsz; u.k0 = 0; u.nt = ntk; return true;
    }
    __device__ __forceinline__ void a_ready(const Unit&) const {}
    __device__ __forceinline__ void done(const Unit&) const {}
};
__device__ __forceinline__ unsigned cvt_pk_bf16(float lo, float hi) { unsigned r; asm volatile("v_cvt_pk_bf16_f32 %0, %1, %2" : "=v"(r) : "v"(lo), "v"(hi)); return r; }
typedef float f32x2 __attribute__((ext_vector_type(2)));
template <class Epi, class Sched, bool ALIGN_EPI = false, bool SP2 = false>
__device__ __forceinline__ void gemm_phase(PG8_LAS unsigned char* lds, const Gemm g, const Sched& S, const Epi& E, const int tid) {
    const int wid = __builtin_amdgcn_readfirstlane(tid >> 6), lane = tid & 63, wr = wid >> 2, wc = wid & 3, fr = lane & 15, fq = lane >> 4;
    const int K = g.K;
    unsigned voffA[2], voffB[2];
#pragma unroll
    for (int i = 0; i < 2; ++i) { int R, C; stage_rc(tid * 16 + i * 8192, R, C); const int Rb = Epi::PERM ? ((R & ~31) + perm32(R & 31)) : R;
        voffA[i] = (unsigned)(R * K + C) * 2u; voffB[i] = (unsigned)(Rb * K + C) * 2u; }
    const size_t kstep = (size_t)(BK * 2);
    const size_t hstep = (size_t)HALF * K * 2;
    const size_t tstep = 2 * hstep;
    const unsigned ldsw = (unsigned)wid * 1024u;
    const int aoff = lds_byte(wr * 64 + fr, fq * 8), boff = lds_byte(wc * 32 + fr, fq * 8);
#define PG8_SA(b, h) (((b) * 2 + (h)) * HTB)
#define PG8_SB(b, h) ((4 + (b) * 2 + (h)) * HTB)
#define PG8_STAGE(bufoff, gbase, voff) do { _Pragma("unroll") for (int _i = 0; _i < 2; ++_i) \
        __builtin_amdgcn_global_load_lds((const unsigned*)((const char*)(gbase) + (voff)[_i]), (PG8_LAS unsigned*)(lds + (bufoff) + ldsw + _i * 8192), 16, 0, 0); } while (0)
#define PG8_LDA(dst, b, h) do { _Pragma("unroll") for (int m = 0; m < 4; ++m) _Pragma("unroll") for (int k = 0; k < 2; ++k) dst[m][k] = *(const PG8_LAS bf16x8*)(lds + PG8_SA(b, h) + aoff + m * 2048 + k * 1024); } while (0)
#define PG8_LDB(dst, b, h) do { _Pragma("unroll") for (int n = 0; n < 2; ++n) _Pragma("unroll") for (int k = 0; k < 2; ++k) dst[n][k] = *(const PG8_LAS bf16x8*)(lds + PG8_SB(b, h) + boff + n * 2048 + k * 1024); } while (0)
#define PG8_MMA(ai, bj, At, Bt) do { __builtin_amdgcn_s_setprio(1); _Pragma("unroll") for (int m = 0; m < 4; ++m) _Pragma("unroll") for (int n = 0; n < 2; ++n) _Pragma("unroll") for (int k = 0; k < 2; ++k) \
        acc[ai][bj][m][n] = __builtin_amdgcn_mfma_f32_16x16x32_bf16(Bt[n][k], At[m][k], acc[ai][bj][m][n], 0, 0, 0); __builtin_amdgcn_s_setprio(0); } while (0)
#define PG8_WAIT_V(n) asm volatile("s_waitcnt vmcnt(" #n ")" ::: "memory")
#define PG8_WAIT_L(n) asm volatile("s_waitcnt lgkmcnt(" #n ")" ::: "memory")
#define PG8_BAR __builtin_amdgcn_s_barrier()
#define PG8_SCHED __builtin_amdgcn_sched_barrier(0)
    Unit cur, nxt; int ui = 0;
    if (!S.next(0, cur)) return;
    f32x4 acc[2][2][4][2];
#pragma unroll
    for (int a = 0; a < 2; ++a)
#pragma unroll
        for (int b = 0; b < 2; ++b)
#pragma unroll
            for (int m = 0; m < 4; ++m)
#pragma unroll
                for (int n = 0; n < 2; ++n) acc[a][b][m][n] = (f32x4){0.f, 0.f, 0.f, 0.f};
    bf16x8 At[4][2], B0[2][2], B1[2][2];
    const char* cA = (const char*)g.A + (size_t)cur.pm * tstep + (size_t)cur.k0 * kstep; const char* cB = (const char*)g.Bt + (size_t)cur.pn * tstep + (size_t)cur.k0 * kstep;
    S.a_ready(cur);
    if constexpr (SP2) {
        PG8_STAGE(PG8_SB(0, 0), cB, voffB); PG8_STAGE(PG8_SB(0, 1), cB + hstep, voffB); PG8_STAGE(PG8_SA(0, 0), cA, voffA); PG8_STAGE(PG8_SA(0, 1), cA + hstep, voffA);
        if (wr == 1) PG8_BAR;
        PG8_WAIT_V(2); PG8_BAR;
        PG8_STAGE(PG8_SB(1, 0), cB + kstep, voffB); PG8_STAGE(PG8_SA(1, 0), cA + kstep, voffA); PG8_STAGE(PG8_SB(1, 1), cB + hstep + kstep, voffB);
        PG8_WAIT_V(6); PG8_BAR;
    } else {
        PG8_STAGE(PG8_SB(0, 0), cB, voffB); PG8_STAGE(PG8_SA(0, 0), cA, voffA); PG8_STAGE(PG8_SB(0, 1), cB + hstep, voffB); PG8_STAGE(PG8_SA(0, 1), cA + hstep, voffA);
        if (wr == 1) PG8_BAR;
        PG8_WAIT_V(4); PG8_BAR;
        PG8_STAGE(PG8_SB(1, 0), cB + kstep, voffB); PG8_STAGE(PG8_SA(1, 0), cA + kstep, voffA); PG8_STAGE(PG8_SB(1, 1), cB + hstep + kstep, voffB);
        PG8_WAIT_V(6); PG8_BAR;
    }
    for (;;) {
        const bool has_next = S.next(ui + 1, nxt);
        const char* nA = has_next ? (const char*)g.A + (size_t)nxt.pm * tstep + (size_t)nxt.k0 * kstep : cA; const char* nB = has_next ? (const char*)g.Bt + (size_t)nxt.pn * tstep + (size_t)nxt.k0 * kstep : cB;
        const int nt = cur.nt;
        for (int t = 0; t < nt; t += 2) {
            const bool last = (t == nt - 2);
            const char* a1 = cA + (size_t)(t + 1) * kstep;
            const char* a2 = last ? nA : cA + (size_t)(t + 2) * kstep; const char* b2 = last ? nB : cB + (size_t)(t + 2) * kstep;
            const char* a3 = a2 + kstep; const char* b3 = b2 + kstep;
            if (last && has_next) S.a_ready(nxt);
            if constexpr (SP2) {
            PG8_LDB(B0, 0, 0); PG8_LDB(B1, 0, 1); PG8_SCHED; PG8_LDA(At, 0, 0); PG8_STAGE(PG8_SA(1, 1), a1 + hstep, voffA);
            PG8_WAIT_V(8); PG8_WAIT_L(0); PG8_BAR; PG8_MMA(0, 0, At, B0); PG8_MMA(0, 1, At, B1); PG8_BAR; PG8_SCHED;
            PG8_LDA(At, 0, 1); PG8_STAGE(PG8_SB(0, 0), b2, voffB); PG8_STAGE(PG8_SB(0, 1), b2 + hstep, voffB); PG8_STAGE(PG8_SA(0, 0), a2, voffA);
            PG8_WAIT_V(8); PG8_WAIT_L(0); PG8_BAR; PG8_MMA(1, 0, At, B0); PG8_MMA(1, 1, At, B1); PG8_BAR; PG8_SCHED;
            PG8_LDB(B0, 1, 0); PG8_LDB(B1, 1, 1); PG8_SCHED; PG8_LDA(At, 1, 0); PG8_STAGE(PG8_SA(0, 1), a2 + hstep, voffA);
            PG8_WAIT_V(8); PG8_WAIT_L(0); PG8_BAR; PG8_MMA(0, 0, At, B0); PG8_MMA(0, 1, At, B1); PG8_BAR; PG8_SCHED;
            PG8_LDA(At, 1, 1); PG8_STAGE(PG8_SB(1, 0), b3, voffB); PG8_STAGE(PG8_SB(1, 1), b3 + hstep, voffB); PG8_STAGE(PG8_SA(1, 0), a3, voffA);
            PG8_WAIT_V(8); PG8_WAIT_L(0); PG8_BAR; PG8_MMA(1, 0, At, B0); PG8_MMA(1, 1, At, B1); PG8_BAR; PG8_SCHED;
            } else {
            PG8_LDB(B0, 0, 0); PG8_SCHED; PG8_LDA(At, 0, 0); PG8_STAGE(PG8_SA(1, 1), a1 + hstep, voffA);
            PG8_WAIT_L(8); PG8_BAR; PG8_WAIT_L(0); PG8_MMA(0, 0, At, B0); PG8_BAR; PG8_SCHED;
            PG8_LDB(B1, 0, 1); PG8_STAGE(PG8_SB(0, 0), b2, voffB);
            PG8_BAR; PG8_WAIT_L(0); PG8_MMA(0, 1, At, B1); PG8_BAR;
            PG8_LDA(At, 0, 1); PG8_STAGE(PG8_SA(0, 0), a2, voffA);
            PG8_BAR; PG8_WAIT_L(0); PG8_MMA(1, 0, At, B0); PG8_BAR; PG8_SCHED;
            PG8_STAGE(PG8_SB(0, 1), b2 + hstep, voffB);
            PG8_WAIT_V(6); PG8_BAR; PG8_MMA(1, 1, At, B1); PG8_BAR;
            PG8_LDB(B0, 1, 0); PG8_SCHED; PG8_LDA(At, 1, 0); PG8_STAGE(PG8_SA(0, 1), a2 + hstep, voffA);
            PG8_WAIT_L(8); PG8_BAR; PG8_WAIT_L(0); PG8_MMA(0, 0, At, B0); PG8_BAR; PG8_SCHED;
            PG8_LDB(B1, 1, 1); PG8_STAGE(PG8_SB(1, 0), b3, voffB);
            PG8_BAR; PG8_WAIT_L(0); PG8_MMA(0, 1, At, B1); PG8_BAR;
            PG8_LDA(At, 1, 1); PG8_STAGE(PG8_SA(1, 0), a3, voffA);
            PG8_BAR; PG8_WAIT_L(0); PG8_MMA(1, 0, At, B0); PG8_BAR; PG8_SCHED;
            PG8_STAGE(PG8_SB(1, 1), b3 + hstep, voffB);
            PG8_WAIT_V(6); PG8_BAR; PG8_MMA(1, 1, At, B1); PG8_BAR;
            }
        }
        if constexpr (ALIGN_EPI) { if (wr == 0) PG8_BAR; }
        if constexpr (!Epi::AFTER_DRAIN) { E(acc, cur, wr, wc, fr, fq); S.done(cur); }
        if (!has_next) break;
#pragma unroll
        for (int a = 0; a < 2; ++a)
#pragma unroll
            for (int b = 0; b < 2; ++b)
#pragma unroll
                for (int m = 0; m < 4; ++m)
#pragma unroll
                    for (int n = 0; n < 2; ++n) acc[a][b][m][n] = (f32x4){0.f, 0.f, 0.f, 0.f};
        cur = nxt; cA = nA; cB = nB; ++ui;
        if constexpr (ALIGN_EPI) { if (wr == 1) PG8_BAR; }
    }
    PG8_WAIT_V(0);
    if constexpr (!ALIGN_EPI) { if (wr == 0) PG8_BAR; }
    PG8_BAR;
    if constexpr (Epi::AFTER_DRAIN) { E.fused(acc, cur, wr, wc, fr, fq, lds, wid, lane); S.done(cur); }
#undef PG8_SA
#undef PG8_SB
#undef PG8_STAGE
#undef PG8_LDA
#undef PG8_LDB
#undef PG8_MMA
#undef PG8_WAIT_V
#undef PG8_WAIT_L
#undef PG8_BAR
#undef PG8_SCHED
}
}

constexpr int D = 1024, NP = 16384, NS = 1024, M = NP + NS, NIN = 4096, FF = 4096, TP = 2048;
constexpr float EPS = 1e-6f;
constexpr int NWAVES = 8, NTHR = 512;
#ifndef MK_N_LAUNCHES
#define MK_N_LAUNCHES 1
#endif
constexpr int N_PHASES = 7;
#ifndef PROBE_MASK
#define PROBE_MASK 0
#endif
#define NREP(k) (((PROBE_MASK >> (k)) & 1) ? 2 : 1)
constexpr size_t MiB = 1u << 20;
constexpr size_t WS_EF = 0;
constexpr size_t WS_WIN = 1 * MiB, WS_WOUT = 9 * MiB, WS_WUP = 11 * MiB, WS_WDN = 19 * MiB, WS_TAB = 27 * MiB, WS_SSQ = 29 * MiB;
constexpr size_t WS_XN = 32 * MiB;
constexpr size_t WS_PROJ = 66 * MiB;
constexpr size_t WS_OB = 202 * MiB;
constexpr size_t WS_CTL = 236 * MiB, CTL_BYTES = 65536;
constexpr size_t WS_END = 237 * MiB;
constexpr size_t OUT_Y = 0, OUT_RSP = (size_t)M * D, OUT_HSP = OUT_RSP + 8 * 4 * 16384, OUT_RSS = OUT_HSP + 8 * 4 * 16384, OUT_HSS = OUT_RSS + (size_t)128 * 4 * 16384;
constexpr int LDS_BYTES = 147456;

#define LAS __attribute__((address_space(3)))
typedef unsigned short bf16;
typedef unsigned v4u __attribute__((ext_vector_type(4)));
typedef unsigned v2u __attribute__((ext_vector_type(2)));
typedef float f32x4 __attribute__((ext_vector_type(4)));
#define LDS_WAIT() asm volatile("s_waitcnt lgkmcnt(0)" ::: "memory")

__device__ __forceinline__ unsigned f2bf(float f) { unsigned u = __builtin_bit_cast(unsigned, f); return (u + 0x7fffu + ((u >> 16) & 1u)) >> 16; }
__device__ __forceinline__ unsigned pk2(float lo, float hi) { return f2bf(lo) | (f2bf(hi) << 16); }
typedef float f32x2_t __attribute__((ext_vector_type(2)));
typedef __bf16 bf16x2_t __attribute__((ext_vector_type(2)));
__device__ __forceinline__ unsigned cvtpk(float lo, float hi) { const f32x2_t v = {lo, hi}; const bf16x2_t b = __builtin_convertvector(v, bf16x2_t); return __builtin_bit_cast(unsigned, b); }
__device__ __forceinline__ float bflo(unsigned u) { return __uint_as_float(u << 16); }
__device__ __forceinline__ float bfhi(unsigned u) { return __uint_as_float(u & 0xffff0000u); }
__device__ __forceinline__ float sigmoidf_(float x) { return __builtin_amdgcn_rcpf(1.0f + __expf(-x)); }
__device__ __forceinline__ float siluf_(float x) { return x * sigmoidf_(x); }
__device__ __forceinline__ float wave_sum(float v) {
#pragma unroll
    for (int o = 1; o < 64; o <<= 1) v += __shfl_xor(v, o);
    return v;
}
__device__ __forceinline__ float log2gamma(int h) { return h == 0 ? -0.04580368961312479f : (h == 1 ? -0.02272007650008353f : (h == 2 ? -0.011315313227834146f : -0.005646563141142063f)); }

__constant__ double INVF[64] = {1.0, 0.8659643233600653, 0.7498942093324559, 0.6493816315762113, 0.5623413251903491, 0.4869675251658631, 0.4216965034285822, 0.3651741272548377, 0.31622776601683794, 0.27384196342643613, 0.23713737056616552, 0.2053525026457146, 0.1778279410038923, 0.1539926526059492, 0.1333521432163324, 0.11547819846894582, 0.1, 0.08659643233600653, 0.07498942093324558, 0.06493816315762113, 0.05623413251903491, 0.04869675251658631, 0.042169650342858224, 0.03651741272548377, 0.03162277660168379, 0.027384196342643614, 0.023713737056616554, 0.02053525026457146, 0.01778279410038923, 0.01539926526059492, 0.01333521432163324, 0.011547819846894581, 0.01, 0.008659643233600654, 0.007498942093324558, 0.006493816315762113, 0.005623413251903491, 0.004869675251658631, 0.004216965034285823, 0.003651741272548377, 0.0031622776601683794, 0.0027384196342643613, 0.0023713737056616554, 0.002053525026457146, 0.0017782794100389228, 0.001539926526059492, 0.001333521432163324, 0.0011547819846894581, 0.001, 0.0008659643233600654, 0.0007498942093324559, 0.0006493816315762113, 0.0005623413251903491, 0.0004869675251658631, 0.00042169650342858224, 0.0003651741272548377, 0.00031622776601683794, 0.0002738419634264361, 0.00023713737056616554, 0.0002053525026457146, 0.00017782794100389227, 0.0001539926526059492, 0.0001333521432163324, 0.00011547819846894582};

using pg8::Unit;

struct EpiProj {
    static constexpr bool PERM = true, AFTER_DRAIN = false;
    bf16* P; const float* tab; const float* lbl; unsigned* hcnt;
    __device__ __forceinline__ void operator()(const f32x4 (&acc)[2][2][4][2], const Unit& u, int wr, int wc, int fr, int fq) const {
        const int type = u.pn >> 1;
        const int row0 = u.pm * 256 + wr * 64 + fr, d0 = wc * 32 + 8 * fq, col0 = u.pn * 256 + d0;
        if (type <= 1) {
#pragma unroll
            for (int ai = 0; ai < 2; ++ai)
#pragma unroll
                for (int m = 0; m < 4; ++m) {
                    const int row = row0 + ai * 128 + m * 16;
                    const int pidx = row < NP ? (row & (TP - 1)) : TP + (row & 7);
                    const f32x4* tp = (const f32x4*)(tab + ((size_t)pidx * 64 + (d0 >> 1)) * 2);
                    const f32x4 cs0 = tp[0], cs1 = tp[1];
                    bf16* rowp = P + (size_t)row * NIN + col0;
#pragma unroll
                    for (int bj = 0; bj < 2; ++bj) {
                        float sc = 1.0f;
                        if (type == 1) { sc = 0.08838834764831845f; if (row < NP) sc *= exp2f(-(float)((row & 63) + 1) * log2gamma(2 * (u.pn & 1) + bj)); }
                        const f32x4 v0 = acc[ai][bj][m][0], v1 = acc[ai][bj][m][1];
                        v4u w;
                        w.x = cvtpk((v0[0] * cs0[0] - v0[1] * cs0[1]) * sc, (v0[0] * cs0[1] + v0[1] * cs0[0]) * sc);
                        w.y = cvtpk((v0[2] * cs0[2] - v0[3] * cs0[3]) * sc, (v0[2] * cs0[3] + v0[3] * cs0[2]) * sc);
                        w.z = cvtpk((v1[0] * cs1[0] - v1[1] * cs1[1]) * sc, (v1[0] * cs1[1] + v1[1] * cs1[0]) * sc);
                        w.w = cvtpk((v1[2] * cs1[2] - v1[3] * cs1[3]) * sc, (v1[2] * cs1[3] + v1[3] * cs1[2]) * sc);
                        *(v4u*)(rowp + bj * 128) = w;
                    }
                    if (m & 1) asm volatile("" ::: "memory");
                }
        } else if (type == 5) {
            float lb[2][8];
#pragma unroll
            for (int bj = 0; bj < 2; ++bj)
#pragma unroll
                for (int i = 0; i < 8; ++i) { const int c = (u.pn & 1) * 256 + bj * 128 + d0 + i; lb[bj][i] = sigmoidf_(lbl[c] - lbl[512 + c]); }
#pragma unroll
            for (int ai = 0; ai < 2; ++ai)
#pragma unroll
                for (int m = 0; m < 4; ++m) {
                    const int row = row0 + ai * 128 + m * 16;
                    bf16* rowp = P + (size_t)row * NIN + col0;
#pragma unroll
                    for (int bj = 0; bj < 2; ++bj) {
                        float o[8];
#pragma unroll
                        for (int i = 0; i < 8; ++i) { const float x = acc[ai][bj][m][i >> 2][i & 3]; const float f = lb[bj][i] + (1.0f - lb[bj][i]) * sigmoidf_(x); o[i] = __logf(f); }
                        v4u w; w.x = cvtpk(o[0], o[1]); w.y = cvtpk(o[2], o[3]); w.z = cvtpk(o[4], o[5]); w.w = cvtpk(o[6], o[7]);
                        *(v4u*)(rowp + bj * 128) = w;
                    }
                }
        } else {
            const bool act = (type == 3) || (type == 4) || (type == 7);
            const float sc = (type == 4) ? 0.08838834764831845f : 1.0f;
#pragma unroll
            for (int ai = 0; ai < 2; ++ai)
#pragma unroll
                for (int m = 0; m < 4; ++m) {
                    const int row = row0 + ai * 128 + m * 16;
                    bf16* rowp = P + (size_t)row * NIN + col0;
#pragma unroll
                    for (int bj = 0; bj < 2; ++bj) {
                        float o[8];
#pragma unroll
                        for (int i = 0; i < 8; ++i) { const float x = acc[ai][bj][m][i >> 2][i & 3]; o[i] = act ? siluf_(x) * sc : x; }
                        v4u w; w.x = cvtpk(o[0], o[1]); w.y = cvtpk(o[2], o[3]); w.z = cvtpk(o[4], o[5]); w.w = cvtpk(o[6], o[7]);
                        *(v4u*)(rowp + bj * 128) = w;
                    }
                }
        }
        if ((type == 4 || type == 5) && u.pm < NP / 256) {
            asm volatile("s_waitcnt vmcnt(0)" ::: "memory");
            __syncthreads();
            if (threadIdx.x == 0) {
                __builtin_amdgcn_fence(__ATOMIC_RELEASE, "agent");
                asm volatile("s_waitcnt vmcnt(0)" ::: "memory");
                __hip_atomic_fetch_add(hcnt, 1u, __ATOMIC_RELAXED, __HIP_MEMORY_SCOPE_AGENT);
            }
        }
    }
};

constexpr int OUT_SPLIT = 4;
struct EpiOut {
    static constexpr bool PERM = true, AFTER_DRAIN = false;
    const float* xp; const float* xs; float* X1; bf16* X1B; float* ssq; float* PART;
    __device__ __forceinline__ void operator()(const f32x4 (&acc)[2][2][4][2], const Unit& u, int wr, int wc, int fr, int fq) const {
        const int row0 = u.pm * 256 + wr * 64 + fr, col0 = u.pn * 256 + wc * 32 + 8 * fq;
        if (u.nt != D / 64) {
            float* pb = PART + (size_t)(u.k0 / u.nt) * ((size_t)NS * D);
#pragma unroll
            for (int ai = 0; ai < 2; ++ai)
#pragma unroll
                for (int m = 0; m < 4; ++m) {
                    float* op = pb + (size_t)(row0 - NP + ai * 128 + m * 16) * D + col0;
#pragma unroll
                    for (int bj = 0; bj < 2; ++bj) { *(f32x4*)(op + bj * 128) = acc[ai][bj][m][0]; *(f32x4*)(op + bj * 128 + 4) = acc[ai][bj][m][1]; }
                }
            return;
        }
#pragma unroll
        for (int ai = 0; ai < 2; ++ai)
#pragma unroll
            for (int m = 0; m < 4; ++m) {
                const int row = row0 + ai * 128 + m * 16;
                const float* xr = (row < NP ? xp + (size_t)row * D : xs + (size_t)(row - NP) * D) + col0;
                bf16* bp = X1B + (size_t)row * D + col0;
                float s = 0.f;
#pragma unroll
                for (int bj = 0; bj < 2; ++bj) {
                    const f32x4 v0 = acc[ai][bj][m][0] + __builtin_nontemporal_load((const f32x4*)(xr + bj * 128)), v1 = acc[ai][bj][m][1] + __builtin_nontemporal_load((const f32x4*)(xr + bj * 128 + 4));
                    v4u w; w.x = cvtpk(v0[0], v0[1]); w.y = cvtpk(v0[2], v0[3]); w.z = cvtpk(v1[0], v1[1]); w.w = cvtpk(v1[2], v1[3]);
                    *(v4u*)(bp + bj * 128) = w;
                    s += (v0[0] * v0[0] + v0[1] * v0[1]) + (v0[2] * v0[2] + v0[3] * v0[3]) + (v1[0] * v1[0] + v1[1] * v1[1]) + (v1[2] * v1[2] + v1[3] * v1[3]);
                }
                s += __shfl_xor(s, 16); s += __shfl_xor(s, 32);
                if (fq == 0) ssq[(size_t)row * 16 + u.pn * 4 + wc] = s;
                if (m == 3) asm volatile("" ::: "memory");
            }
    }
};

struct OutOrder {
    int G, c; pg8::StaticOrder P;
    __host__ __device__ void init(int G_, int c_) { G = G_; c = c_; P.init(NP, D, G_, c_, D); }
    __host__ __device__ bool next(int i, Unit& u) const {
        const int L = i * G + c;
        if (L < 256) return P.next(i, u);
        const int s = L - 256; if (s >= 16 * OUT_SPLIT) return false;
        const int tile = s / OUT_SPLIT, ks = s % OUT_SPLIT;
        u.pm = NP / 256 + (tile >> 2); u.pn = tile & 3; u.nt = (D / 64) / OUT_SPLIT; u.k0 = ks * u.nt; return true;
    }
    __device__ __forceinline__ void a_ready(const Unit&) const {}
    __device__ __forceinline__ void done(const Unit&) const {}
};
__device__ __forceinline__ void sample_out_reduce(const float* xrow, const float* part, float* x1row, bf16* x1brow, float* r2out, int lane) {
    f32x4 v[4]; float s = 0.f;
#pragma unroll
    for (int j = 0; j < 4; ++j) v[j] = ((const f32x4*)xrow)[lane + 64 * j];
#pragma unroll
    for (int ks = 0; ks < OUT_SPLIT; ++ks)
#pragma unroll
        for (int j = 0; j < 4; ++j) v[j] += __builtin_nontemporal_load((const f32x4*)(part + (size_t)ks * NS * D) + lane + 64 * j);
#pragma unroll
    for (int j = 0; j < 4; ++j) { s += (v[j][0] * v[j][0] + v[j][1] * v[j][1]) + (v[j][2] * v[j][2] + v[j][3] * v[j][3]); ((f32x4*)x1row)[lane + 64 * j] = v[j];
        ((unsigned long long*)x1brow)[lane + 64 * j] = (unsigned long long)cvtpk(v[j][0], v[j][1]) | ((unsigned long long)cvtpk(v[j][2], v[j][3]) << 32); }
    s = wave_sum(s);
    if (lane == 0) *r2out = 1.0f / (s * (1.0f / D) + EPS);
}

struct EpiUp {
    static constexpr bool PERM = true, AFTER_DRAIN = false;
    bf16* H; const float* r2v;
    __device__ __forceinline__ void operator()(const f32x4 (&acc)[2][2][4][2], const Unit& u, int wr, int wc, int fr, int fq) const {
        const int row0 = u.pm * 256 + wr * 64 + fr, col0 = u.pn * 256 + wc * 32 + 8 * fq;
        float r2[2][4];
#pragma unroll
        for (int ai = 0; ai < 2; ++ai)
#pragma unroll
            for (int m = 0; m < 4; ++m) r2[ai][m] = r2v[row0 + ai * 128 + m * 16];
#pragma unroll
        for (int ai = 0; ai < 2; ++ai)
#pragma unroll
            for (int m = 0; m < 4; ++m) {
                const int row = row0 + ai * 128 + m * 16;
                bf16* hp = H + (size_t)row * FF + col0;
#pragma unroll
                for (int bj = 0; bj < 2; ++bj) {
                    float o[8];
#pragma unroll
                    for (int i = 0; i < 8; ++i) { const float x = fmaxf(acc[ai][bj][m][i >> 2][i & 3], 0.f); o[i] = x * x * r2[ai][m]; }
                    v4u w; w.x = cvtpk(o[0], o[1]); w.y = cvtpk(o[2], o[3]); w.z = cvtpk(o[4], o[5]); w.w = cvtpk(o[6], o[7]);
                    *(v4u*)(hp + bj * 128) = w;
                }
            }
    }
};

constexpr int DN_SPLIT = 8;
struct EpiDown {
    static constexpr bool PERM = true, AFTER_DRAIN = false;
    bf16* XB; float* PART;
    __device__ __forceinline__ void operator()(const f32x4 (&acc)[2][2][4][2], const Unit& u, int wr, int wc, int fr, int fq) const {
        const int row0 = u.pm * 256 + wr * 64 + fr, col0 = u.pn * 256 + wc * 32 + 8 * fq;
        if (u.nt == FF / 64) {
#pragma unroll
            for (int ai = 0; ai < 2; ++ai)
#pragma unroll
                for (int m = 0; m < 4; ++m) {
                    bf16* op = XB + (size_t)(row0 + ai * 128 + m * 16) * D + col0;
#pragma unroll
                    for (int bj = 0; bj < 2; ++bj) {
                        const v4u b = *(const v4u*)(op + bj * 128);
                        const f32x4 v0 = acc[ai][bj][m][0] + (f32x4){bflo(b.x), bfhi(b.x), bflo(b.y), bfhi(b.y)}, v1 = acc[ai][bj][m][1] + (f32x4){bflo(b.z), bfhi(b.z), bflo(b.w), bfhi(b.w)};
                        *(v4u*)(op + bj * 128) = (v4u){cvtpk(v0[0], v0[1]), cvtpk(v0[2], v0[3]), cvtpk(v1[0], v1[1]), cvtpk(v1[2], v1[3])};
                    }
                }
        } else {
            float* pb = PART + (size_t)(u.k0 / u.nt) * ((size_t)NS * D);
#pragma unroll
            for (int ai = 0; ai < 2; ++ai)
#pragma unroll
                for (int m = 0; m < 4; ++m) {
                    float* op = pb + (size_t)(row0 - NP + ai * 128 + m * 16) * D + col0;
#pragma unroll
                    for (int bj = 0; bj < 2; ++bj) { *(f32x4*)(op + bj * 128) = acc[ai][bj][m][0]; *(f32x4*)(op + bj * 128 + 4) = acc[ai][bj][m][1]; }
                }
        }
    }
};
struct DownOrder {
    int G, c; pg8::StaticOrder P;
    __host__ __device__ void init(int G_, int c_) { G = G_; c = c_; P.init(NP, D, G_, c_, FF); }
    __host__ __device__ bool next(int i, Unit& u) const {
        const int L = i * G + c;
        if (L < 256) return P.next(i, u);
        const int s = L - 256; if (s >= 16 * DN_SPLIT) return false;
        const int tile = s / DN_SPLIT, ks = s % DN_SPLIT;
        u.pm = NP / 256 + (tile >> 2); u.pn = tile & 3; u.nt = (FF / 64) / DN_SPLIT; u.k0 = ks * u.nt; return true;
    }
    __device__ __forceinline__ void a_ready(const Unit&) const {}
    __device__ __forceinline__ void done(const Unit&) const {}
};

__device__ __forceinline__ int wmap_in(int n) { if (n < 1024) { const int d = n & 127; return (n & ~127) | ((d & 63) << 1) | (d >> 6); } return n; }
template <bool MAP>
__device__ __forceinline__ void p0_transpose_item(const float* W, int K, int N, bf16* WT, const float* kscale, LAS float* scr, int item, int lane) {
    const int nblk = N / 32, kb = item / nblk, nb = item % nblk, k0 = 64 * kb, n0 = 32 * nb;
    f32x4 wv[8];
#pragma unroll
    for (int i = 0; i < 8; ++i) wv[i] = __builtin_nontemporal_load((const f32x4*)(W + (size_t)(k0 + 8 * i + (lane >> 3)) * N + n0 + 4 * (lane & 7)));
#pragma unroll
    for (int i = 0; i < 8; ++i) { const int kk = 8 * i + (lane >> 3); f32x4 w = wv[i]; if (kscale) w *= kscale[k0 + kk];
        LAS float* d = scr + kk * 33 + 4 * (lane & 7); d[0] = w[0]; d[1] = w[1]; d[2] = w[2]; d[3] = w[3]; }
    LDS_WAIT(); asm volatile("" ::: "memory");
    const int c = lane & 7;
#pragma unroll
    for (int j = 0; j < 4; ++j) { const int n = (lane >> 3) + 8 * j; const LAS float* s = scr + (8 * c) * 33 + n;
        v4u o; o.x = cvtpk(s[0 * 33], s[1 * 33]); o.y = cvtpk(s[2 * 33], s[3 * 33]); o.z = cvtpk(s[4 * 33], s[5 * 33]); o.w = cvtpk(s[6 * 33], s[7 * 33]);
        const int nd = MAP ? wmap_in(n0 + n) : (n0 + n);
        *(v4u*)(WT + (size_t)nd * K + k0 + 8 * c) = o; }
    LDS_WAIT(); asm volatile("" ::: "memory");
}
__device__ __forceinline__ void rms_row_to_bf16(const float* xrow, const float* w, bf16* orow, int lane) {
    const f32x4* xr = (const f32x4*)xrow + lane; const f32x4* wr_ = (const f32x4*)w + lane;
    f32x4 v[4]; float s = 0.f;
#pragma unroll
    for (int j = 0; j < 4; ++j) { v[j] = __builtin_nontemporal_load(xr + 64 * j); s += (v[j][0] * v[j][0] + v[j][1] * v[j][1]) + (v[j][2] * v[j][2] + v[j][3] * v[j][3]); }
    const float rstd = rsqrtf(wave_sum(s) * (1.f / D) + EPS);
    unsigned long long* o8 = (unsigned long long*)orow + lane;
#pragma unroll
    for (int j = 0; j < 4; ++j) { const f32x4 ww = wr_[64 * j]; const f32x4 o = v[j] * rstd * ww; o8[64 * j] = (unsigned long long)cvtpk(o[0], o[1]) | ((unsigned long long)cvtpk(o[2], o[3]) << 32); }
}
__device__ __forceinline__ void rms_row_from_bf16(const bf16* xrow, float* yrow, const float* w, int lane) {
    const unsigned long long* xr = (const unsigned long long*)xrow + lane; const f32x4* wr_ = (const f32x4*)w + lane;
    f32x4 v[4]; float s = 0.f;
#pragma unroll
    for (int j = 0; j < 4; ++j) { const unsigned long long u = xr[64 * j]; const unsigned lo = (unsigned)u, hi = (unsigned)(u >> 32); v[j] = (f32x4){bflo(lo), bfhi(lo), bflo(hi), bfhi(hi)}; s += (v[j][0] * v[j][0] + v[j][1] * v[j][1]) + (v[j][2] * v[j][2] + v[j][3] * v[j][3]); }
    const float rstd = rsqrtf(wave_sum(s) * (1.f / D) + EPS);
#pragma unroll
    for (int j = 0; j < 4; ++j) ((f32x4*)yrow)[lane + 64 * j] = v[j] * rstd * wr_[64 * j];
}
__device__ __forceinline__ void rms_row2_from_bf16(const bf16* xa, float* ya, const bf16* xb, float* yb, const float* w, int lane) {
    const unsigned long long* pa = (const unsigned long long*)xa + lane; const unsigned long long* pb = (const unsigned long long*)(xb ? xb : xa) + lane; const f32x4* wr_ = (const f32x4*)w + lane;
    unsigned long long ua[4], ub[4];
#pragma unroll
    for (int j = 0; j < 4; ++j) { ua[j] = __builtin_nontemporal_load(pa + 64 * j); ub[j] = __builtin_nontemporal_load(pb + 64 * j); }
    f32x4 va[4], vb[4]; float sa = 0.f, sb = 0.f;
#pragma unroll
    for (int j = 0; j < 4; ++j) { const unsigned al = (unsigned)ua[j], ah = (unsigned)(ua[j] >> 32), bl = (unsigned)ub[j], bh = (unsigned)(ub[j] >> 32);
        va[j] = (f32x4){bflo(al), bfhi(al), bflo(ah), bfhi(ah)}; vb[j] = (f32x4){bflo(bl), bfhi(bl), bflo(bh), bfhi(bh)};
        sa += (va[j][0] * va[j][0] + va[j][1] * va[j][1]) + (va[j][2] * va[j][2] + va[j][3] * va[j][3]); sb += (vb[j][0] * vb[j][0] + vb[j][1] * vb[j][1]) + (vb[j][2] * vb[j][2] + vb[j][3] * vb[j][3]); }
    const float ra = rsqrtf(wave_sum(sa) * (1.f / D) + EPS), rb = rsqrtf(wave_sum(sb) * (1.f / D) + EPS);
#pragma unroll
    for (int j = 0; j < 4; ++j) { const f32x4 ww = wr_[64 * j]; __builtin_nontemporal_store(va[j] * ra * ww, (f32x4*)ya + lane + 64 * j); if (xb) __builtin_nontemporal_store(vb[j] * rb * ww, (f32x4*)yb + lane + 64 * j); }
}
__device__ __forceinline__ void rms_row_inplace(float* xrow, const float* w, int lane, const float* part) {
    f32x4* xr = (f32x4*)xrow + lane; const f32x4* wr_ = (const f32x4*)w + lane;
    f32x4 v[4]; float s = 0.f;
#pragma unroll
    for (int j = 0; j < 4; ++j) v[j] = xr[64 * j];
    if (part) {
#pragma unroll
        for (int ks = 0; ks < DN_SPLIT; ++ks)
#pragma unroll
            for (int j = 0; j < 4; ++j) v[j] += __builtin_nontemporal_load((const f32x4*)(part + (size_t)ks * NS * D) + lane + 64 * j);
    }
#pragma unroll
    for (int j = 0; j < 4; ++j) { s += (v[j][0] * v[j][0] + v[j][1] * v[j][1]) + (v[j][2] * v[j][2] + v[j][3] * v[j][3]); }
    const float rstd = rsqrtf(wave_sum(s) * (1.f / D) + EPS);
#pragma unroll
    for (int j = 0; j < 4; ++j) xr[64 * j] = v[j] * rstd * wr_[64 * j];
}

template <bool HG>
__device__ __forceinline__ void rec_unit(LAS unsigned char* lds, const bf16* proj, bf16* OB, const float* normw, size_t row0, int T, int h, bool prompt, const float* s_in, float* s_out, int tid) {
    const int w = __builtin_amdgcn_readfirstlane(tid >> 6), lane = tid & 63, dq = lane >> 2, vq = lane & 3;
    const int colq = (HG ? 2048 : 0) + 128 * h, colk = colq + 512, colv = colq + 1024, colg = colq + 1536, colo = (HG ? 512 : 0) + 128 * h;
    LAS bf16* Qs = (LAS bf16*)lds; LAS bf16* Ks = Qs + 64 * 128; LAS bf16* Vs = Ks + 64 * 128; LAS float* Os = (LAS float*)(lds + 49152);
    float S[8][4];
    const int vcol = 16 * w + 4 * vq;
#pragma unroll
    for (int i = 0; i < 8; ++i) { const int p = 8 * dq + i, d = HG ? p : ((p >> 1) + 64 * (p & 1));
        if (s_in) { const f32x4 t = *(const f32x4*)(s_in + (size_t)d * 128 + vcol); S[i][0] = t[0]; S[i][1] = t[1]; S[i][2] = t[2]; S[i][3] = t[3]; }
        else { S[i][0] = 0.f; S[i][1] = 0.f; S[i][2] = 0.f; S[i][3] = 0.f; } }
    const float l2g = log2gamma(h), gam = exp2f(l2g);
    for (int t0 = 0; t0 < T; t0 += 64) {
        const int TC = (T - t0) < 64 ? (T - t0) : 64;
        __syncthreads();
        for (int i = tid; i < TC * 16; i += NTHR) { const int r = i >> 4, c = i & 15; const bf16* src = proj + (row0 + t0 + r) * NIN + c * 8;
            *(LAS v4u*)(Qs + r * 128 + c * 8) = *(const v4u*)(src + colq); *(LAS v4u*)(Ks + r * 128 + c * 8) = *(const v4u*)(src + colk); *(LAS v4u*)(Vs + r * 128 + c * 8) = *(const v4u*)(src + colv); }
        __syncthreads();
        for (int t = 0; t < TC; ++t) {
            const v4u qu = *(const LAS v4u*)(Qs + t * 128 + 8 * dq), ku = *(const LAS v4u*)(Ks + t * 128 + 8 * dq); const v2u vu = *(const LAS v2u*)(Vs + t * 128 + vcol);
            float q[8], k[8], f[8], v[4];
            q[0] = bflo(qu.x); q[1] = bfhi(qu.x); q[2] = bflo(qu.y); q[3] = bfhi(qu.y); q[4] = bflo(qu.z); q[5] = bfhi(qu.z); q[6] = bflo(qu.w); q[7] = bfhi(qu.w);
            k[0] = bflo(ku.x); k[1] = bfhi(ku.x); k[2] = bflo(ku.y); k[3] = bfhi(ku.y); k[4] = bflo(ku.z); k[5] = bfhi(ku.z); k[6] = bflo(ku.w); k[7] = bfhi(ku.w);
            v[0] = bflo(vu.x); v[1] = bfhi(vu.x); v[2] = bflo(vu.y); v[3] = bfhi(vu.y);
            if (HG) {
#pragma unroll
                for (int i = 0; i < 8; ++i) { f[i] = __expf(k[i]); k[i] = 1.0f - f[i]; }
            } else {
                const float ks = prompt ? exp2f((float)(((t0 + t) & 63) + 1) * l2g) : 1.0f;
#pragma unroll
                for (int i = 0; i < 8; ++i) { f[i] = gam; k[i] *= ks; }
            }
            float o[4] = {0.f, 0.f, 0.f, 0.f};
#pragma unroll
            for (int i = 0; i < 8; ++i)
#pragma unroll
                for (int c = 0; c < 4; ++c) { S[i][c] = f[i] * S[i][c] + k[i] * v[c]; o[c] += q[i] * S[i][c]; }
#pragma unroll
            for (int c = 0; c < 4; ++c) { o[c] += __shfl_xor(o[c], 4); o[c] += __shfl_xor(o[c], 8); o[c] += __shfl_xor(o[c], 16); o[c] += __shfl_xor(o[c], 32); }
            if (dq == 0) *(LAS f32x4*)(Os + t * 128 + vcol) = (f32x4){o[0], o[1], o[2], o[3]};
        }
        __syncthreads();
        {
            const int r = tid >> 3, seg = tid & 7;
            if (r < TC) {
                float x[16]; float s = 0.f;
#pragma unroll
                for (int i = 0; i < 4; ++i) { const f32x4 t = *(const LAS f32x4*)(Os + r * 128 + seg * 16 + 4 * i); x[4 * i] = t[0]; x[4 * i + 1] = t[1]; x[4 * i + 2] = t[2]; x[4 * i + 3] = t[3]; s += (t[0] * t[0] + t[1] * t[1]) + (t[2] * t[2] + t[3] * t[3]); }
                s += __shfl_xor(s, 1); s += __shfl_xor(s, 2); s += __shfl_xor(s, 4);
                const float rstd = rsqrtf(s * (1.0f / 128.0f) + EPS);
                const bf16* gp = proj + (row0 + t0 + r) * NIN + colg + seg * 16;
                const v4u g0 = *(const v4u*)gp, g1 = *(const v4u*)(gp + 8);
                const unsigned gu[8] = {g0.x, g0.y, g0.z, g0.w, g1.x, g1.y, g1.z, g1.w};
                unsigned ou[8];
#pragma unroll
                for (int i = 0; i < 8; ++i) { const float a = x[2 * i] * rstd * normw[seg * 16 + 2 * i] * bflo(gu[i]), b = x[2 * i + 1] * rstd * normw[seg * 16 + 2 * i + 1] * bfhi(gu[i]); ou[i] = cvtpk(a, b); }
                bf16* op = OB + (row0 + t0 + r) * D + colo + seg * 16;
                *(v4u*)op = (v4u){ou[0], ou[1], ou[2], ou[3]}; *(v4u*)(op + 8) = (v4u){ou[4], ou[5], ou[6], ou[7]};
            }
        }
    }
#pragma unroll
    for (int i = 0; i < 8; ++i) { const int p = 8 * dq + i, d = HG ? p : ((p >> 1) + 64 * (p & 1)); *(f32x4*)(s_out + (size_t)d * 128 + vcol) = (f32x4){S[i][0], S[i][1], S[i][2], S[i][3]}; }
}


template <int CTRL, int RMASK> __device__ __forceinline__ float dpp0(float x) { return __builtin_bit_cast(float, __builtin_amdgcn_update_dpp(0, __builtin_bit_cast(int, x), CTRL, RMASK, 0xf, false)); }
__device__ __forceinline__ float wave_incl_scan(float x) {
#if !defined(SCAN_SHFL)
    x += dpp0<0x111, 0xf>(x); x += dpp0<0x112, 0xf>(x); x += dpp0<0x114, 0xf>(x); x += dpp0<0x118, 0xf>(x);
    x += dpp0<0x142, 0xa>(x); x += dpp0<0x143, 0xc>(x);
#else
    const int l_ = (int)__builtin_amdgcn_mbcnt_hi(~0u, __builtin_amdgcn_mbcnt_lo(~0u, 0u));
#pragma unroll
    for (int off = 1; off < 64; off <<= 1) { const float t = __shfl_up(x, off); if (l_ >= off) x += t; }
#endif
    return x;
}
__device__ __forceinline__ float rdlane(float x, int l) { return __builtin_bit_cast(float, __builtin_amdgcn_readlane(__builtin_bit_cast(int, x), l)); }
__device__ __forceinline__ void hg_prep_compute(const v4u qv, const v4u gv, bf16* outp, float* ef, int lane) {
    const unsigned qu[4] = {qv.x, qv.y, qv.z, qv.w}, gu[4] = {gv.x, gv.y, gv.z, gv.w};
    float qp[8], kp[8], e8[8], f8[8];
#pragma unroll
    for (int i = 0; i < 8; ++i) {
        const float q = (i & 1) ? bfhi(qu[i >> 1]) : bflo(qu[i >> 1]), gg = (i & 1) ? bfhi(gu[i >> 1]) : bflo(gu[i >> 1]);
        const float bs = wave_incl_scan(gg);
        const float b32 = rdlane(bs, 31), b63 = rdlane(bs, 63);
        float dlt = bs - b32; dlt = fminf(fmaxf(dlt, -80.f), 80.f);
        qp[i] = q * __expf(dlt); kp[i] = (1.0f - __expf(gg)) * __expf(-dlt);
        e8[i] = __expf(b32); f8[i] = __expf(b63 - b32);
    }
    *(v4u*)outp = (v4u){cvtpk(qp[0], qp[1]), cvtpk(qp[2], qp[3]), cvtpk(qp[4], qp[5]), cvtpk(qp[6], qp[7])};
    *(v4u*)(outp + 512) = (v4u){cvtpk(kp[0], kp[1]), cvtpk(kp[2], kp[3]), cvtpk(kp[4], kp[5]), cvtpk(kp[6], kp[7])};
    if (lane == 0) {
        *(f32x4*)ef = (f32x4){e8[0], e8[1], e8[2], e8[3]}; *(f32x4*)(ef + 4) = (f32x4){e8[4], e8[5], e8[6], e8[7]};
        *(f32x4*)(ef + 128) = (f32x4){f8[0], f8[1], f8[2], f8[3]}; *(f32x4*)(ef + 132) = (f32x4){f8[4], f8[5], f8[6], f8[7]};
    }
}
__device__ __forceinline__ void hg_prep_item2(const bf16* proj, bf16* qkp, float* EF, int itemA, int itemB, int lane) {
    const int ccA = itemA & 15, cA = (itemA >> 4) & 31, hA = (itemA >> 9) & 3, bA = itemA >> 11;
    const int ccB = itemB & 15, cB = (itemB >> 4) & 31, hB = (itemB >> 9) & 3, bB = itemB >> 11;
    const bf16* rA = proj + ((size_t)bA * TP + 64 * cA + lane) * NIN + 2048 + 128 * hA + 8 * ccA;
    const bf16* rB = proj + ((size_t)bB * TP + 64 * cB + lane) * NIN + 2048 + 128 * hB + 8 * ccB;
    const v4u qA = *(const v4u*)rA, gA = *(const v4u*)(rA + 512), qB = *(const v4u*)rB, gB = *(const v4u*)(rB + 512);
    hg_prep_compute(qA, gA, qkp + ((size_t)bA * TP + 64 * cA + lane) * 1024 + 128 * hA + 8 * ccA, EF + ((size_t)((bA * 4 + hA) * 32 + cA)) * 256 + 8 * ccA, lane);
    hg_prep_compute(qB, gB, qkp + ((size_t)bB * TP + 64 * cB + lane) * 1024 + 128 * hB + 8 * ccB, EF + ((size_t)((bB * 4 + hB) * 32 + cB)) * 256 + 8 * ccB, lane);
}

template <bool HG>
__device__ __forceinline__ void rec_unit8(LAS unsigned char* lds, const bf16* proj, bf16* OB, const float* normw, size_t row0, int h, const float* s_in, float* s_out, int tid) {
    const int w = __builtin_amdgcn_readfirstlane(tid >> 6), lane = tid & 63, dq = lane >> 2, vq = lane & 3;
    const int colq = (HG ? 2048 : 0) + 128 * h, colk = colq + 512, colv = colq + 1024, colg = colq + 1536, colo = (HG ? 512 : 0) + 128 * h;
    LAS bf16* Qs = (LAS bf16*)lds; LAS bf16* Ks = Qs + 64 * 128; LAS bf16* Vs = Ks + 64 * 128; LAS float* Os = (LAS float*)(lds + 49152);
    const int vcol = 16 * w + 4 * vq;
    v4u tq = (v4u){0u, 0u, 0u, 0u}, tk = tq, tv = tq, g0 = tq, g1 = tq; float nw[16];
    const int pr = tid >> 4, pcn = tid & 15;
    if (tid < 128) { const bf16* src = proj + (row0 + pr) * NIN + pcn * 8; tq = *(const v4u*)(src + colq); tk = *(const v4u*)(src + colk); tv = *(const v4u*)(src + colv); }
    const int er = tid >> 3, eseg = tid & 7;
    if (tid < 64) { const bf16* gp = proj + (row0 + er) * NIN + colg + eseg * 16; g0 = *(const v4u*)gp; g1 = *(const v4u*)(gp + 8); }
#pragma unroll
    for (int i = 0; i < 16; ++i) nw[i] = normw[eseg * 16 + i];
    float S[8][4];
#pragma unroll
    for (int i = 0; i < 8; ++i) { const int p = 8 * dq + i, d = HG ? p : ((p >> 1) + 64 * (p & 1));
        const f32x4 t = *(const f32x4*)(s_in + (size_t)d * 128 + vcol); S[i][0] = t[0]; S[i][1] = t[1]; S[i][2] = t[2]; S[i][3] = t[3]; }
    const float gam = exp2f(log2gamma(h));
    __syncthreads();
    if (tid < 128) { *(LAS v4u*)(Qs + pr * 128 + pcn * 8) = tq; *(LAS v4u*)(Ks + pr * 128 + pcn * 8) = tk; *(LAS v4u*)(Vs + pr * 128 + pcn * 8) = tv; }
    __syncthreads();
#pragma unroll 2
    for (int t = 0; t < 8; ++t) {
        const v4u qu = *(const LAS v4u*)(Qs + t * 128 + 8 * dq), ku = *(const LAS v4u*)(Ks + t * 128 + 8 * dq); const v2u vu = *(const LAS v2u*)(Vs + t * 128 + vcol);
        float q[8], k[8], f[8], v[4];
        q[0] = bflo(qu.x); q[1] = bfhi(qu.x); q[2] = bflo(qu.y); q[3] = bfhi(qu.y); q[4] = bflo(qu.z); q[5] = bfhi(qu.z); q[6] = bflo(qu.w); q[7] = bfhi(qu.w);
        k[0] = bflo(ku.x); k[1] = bfhi(ku.x); k[2] = bflo(ku.y); k[3] = bfhi(ku.y); k[4] = bflo(ku.z); k[5] = bfhi(ku.z); k[6] = bflo(ku.w); k[7] = bfhi(ku.w);
        v[0] = bflo(vu.x); v[1] = bfhi(vu.x); v[2] = bflo(vu.y); v[3] = bfhi(vu.y);
        if (HG) {
#pragma unroll
            for (int i = 0; i < 8; ++i) { f[i] = __expf(k[i]); k[i] = 1.0f - f[i]; }
        } else {
#pragma unroll
            for (int i = 0; i < 8; ++i) f[i] = gam;
        }
        float o[4] = {0.f, 0.f, 0.f, 0.f};
#pragma unroll
        for (int i = 0; i < 8; ++i)
#pragma unroll
            for (int c = 0; c < 4; ++c) { S[i][c] = f[i] * S[i][c] + k[i] * v[c]; o[c] += q[i] * S[i][c]; }
#pragma unroll
        for (int c = 0; c < 4; ++c) { o[c] += __shfl_xor(o[c], 4); o[c] += __shfl_xor(o[c], 8); o[c] += __shfl_xor(o[c], 16); o[c] += __shfl_xor(o[c], 32); }
        if (dq == 0) *(LAS f32x4*)(Os + t * 128 + vcol) = (f32x4){o[0], o[1], o[2], o[3]};
    }
    __syncthreads();
    if (tid < 64) {
        float x[16]; float s = 0.f;
#pragma unroll
        for (int i = 0; i < 4; ++i) { const f32x4 t = *(const LAS f32x4*)(Os + er * 128 + eseg * 16 + 4 * i); x[4 * i] = t[0]; x[4 * i + 1] = t[1]; x[4 * i + 2] = t[2]; x[4 * i + 3] = t[3]; s += (t[0] * t[0] + t[1] * t[1]) + (t[2] * t[2] + t[3] * t[3]); }
        s += __shfl_xor(s, 1); s += __shfl_xor(s, 2); s += __shfl_xor(s, 4);
        const float rstd = rsqrtf(s * (1.0f / 128.0f) + EPS);
        const unsigned gu[8] = {g0.x, g0.y, g0.z, g0.w, g1.x, g1.y, g1.z, g1.w};
        unsigned ou[8];
#pragma unroll
        for (int i = 0; i < 8; ++i) { const float a = x[2 * i] * rstd * nw[2 * i] * bflo(gu[i]), b = x[2 * i + 1] * rstd * nw[2 * i + 1] * bfhi(gu[i]); ou[i] = cvtpk(a, b); }
        bf16* op = OB + (row0 + er) * D + colo + eseg * 16;
        *(v4u*)op = (v4u){ou[0], ou[1], ou[2], ou[3]}; *(v4u*)(op + 8) = (v4u){ou[4], ou[5], ou[6], ou[7]};
    }
#pragma unroll
    for (int i = 0; i < 8; ++i) { const int p = 8 * dq + i, d = HG ? p : ((p >> 1) + 64 * (p & 1)); *(f32x4*)(s_out + (size_t)d * 128 + vcol) = (f32x4){S[i][0], S[i][1], S[i][2], S[i][3]}; }
}


__device__ __forceinline__ float dpp_rr_add(float x) {
    x += __builtin_bit_cast(float, __builtin_amdgcn_update_dpp(0, __builtin_bit_cast(int, x), 0x124, 0xf, 0xf, false));
    x += __builtin_bit_cast(float, __builtin_amdgcn_update_dpp(0, __builtin_bit_cast(int, x), 0x128, 0xf, 0xf, false));
    return x;
}
template <bool HG>
__device__ __forceinline__ void rec_units8(LAS unsigned char* lds, const bf16* proj, bf16* OB, const float* normw, const float* st, float* so, int u0, int ustep, int uend, int h, int tid) {
    const int w = __builtin_amdgcn_readfirstlane(tid >> 6), lane = tid & 63, dq = lane >> 2, vq = lane & 3;
    const int colq = (HG ? 2048 : 0) + 128 * h, colk = colq + 512, colv = colq + 1024, colg = colq + 1536, colo = (HG ? 512 : 0) + 128 * h;
    LAS bf16* Qs = (LAS bf16*)lds; LAS bf16* Ks = Qs + 64 * 128; LAS bf16* Vs = Ks + 64 * 128; LAS float* Os = (LAS float*)(lds + 49152);
    const int vcol = 16 * w + 4 * vq, pr = tid >> 4, pcn = tid & 15, er = tid >> 3, eseg = tid & 7;
    float nw[16];
#pragma unroll
    for (int i = 0; i < 16; ++i) nw[i] = normw[eseg * 16 + i];
    const float gam = exp2f(log2gamma(h));
    const v4u z4 = (v4u){0u, 0u, 0u, 0u};
    v4u tq = z4, tk = z4, tv = z4, g0 = z4, g1 = z4, nq = z4, nk = z4, nv = z4, n0 = z4, n1 = z4;
    f32x4 S4[8], N4[8];
#pragma unroll
    for (int i = 0; i < 8; ++i) { S4[i] = (f32x4){0.f, 0.f, 0.f, 0.f}; N4[i] = S4[i]; }
#define RU8_ISSUE(u_, TQ, TK, TV, G0, G1, SS) do { const int bs_ = (u_) >> 3; const size_t r0_ = (size_t)NP + (size_t)bs_ * 8; \
        if (tid < 128) { const bf16* src_ = proj + (r0_ + pr) * NIN + pcn * 8; TQ = *(const v4u*)(src_ + colq); TK = *(const v4u*)(src_ + colk); TV = *(const v4u*)(src_ + colv); } \
        if (tid < 64) { const bf16* gp_ = proj + (r0_ + er) * NIN + colg + eseg * 16; G0 = *(const v4u*)gp_; G1 = *(const v4u*)(gp_ + 8); } \
        const float* sin_ = st + (size_t)(bs_ * 4 + h) * 16384; \
        _Pragma("unroll") for (int i_ = 0; i_ < 8; ++i_) { const int p_ = 8 * dq + i_, d_ = HG ? p_ : ((p_ >> 1) + 64 * (p_ & 1)); SS[i_] = *(const f32x4*)(sin_ + (size_t)d_ * 128 + vcol); } } while (0)
    if (u0 < uend) RU8_ISSUE(u0, tq, tk, tv, g0, g1, S4);
    for (int u = u0; u < uend; u += ustep) {
        const int un = u + ustep, bs = u >> 3; const size_t row0 = (size_t)NP + (size_t)bs * 8;
        if (un < uend) RU8_ISSUE(un, nq, nk, nv, n0, n1, N4);
        __syncthreads();
        if (tid < 128) { *(LAS v4u*)(Qs + pr * 128 + pcn * 8) = tq; *(LAS v4u*)(Ks + pr * 128 + pcn * 8) = tk; *(LAS v4u*)(Vs + pr * 128 + pcn * 8) = tv; }
        __syncthreads();
#pragma unroll 2
        for (int t = 0; t < 8; ++t) {
            const v4u qu = *(const LAS v4u*)(Qs + t * 128 + 8 * dq), ku = *(const LAS v4u*)(Ks + t * 128 + 8 * dq); const v2u vu = *(const LAS v2u*)(Vs + t * 128 + vcol);
            float q[8], k[8], f[8], v[4];
            q[0] = bflo(qu.x); q[1] = bfhi(qu.x); q[2] = bflo(qu.y); q[3] = bfhi(qu.y); q[4] = bflo(qu.z); q[5] = bfhi(qu.z); q[6] = bflo(qu.w); q[7] = bfhi(qu.w);
            k[0] = bflo(ku.x); k[1] = bfhi(ku.x); k[2] = bflo(ku.y); k[3] = bfhi(ku.y); k[4] = bflo(ku.z); k[5] = bfhi(ku.z); k[6] = bflo(ku.w); k[7] = bfhi(ku.w);
            v[0] = bflo(vu.x); v[1] = bfhi(vu.x); v[2] = bflo(vu.y); v[3] = bfhi(vu.y);
            if (HG) {
#pragma unroll
                for (int i = 0; i < 8; ++i) { f[i] = __expf(k[i]); k[i] = 1.0f - f[i]; }
            } else {
#pragma unroll
                for (int i = 0; i < 8; ++i) f[i] = gam;
            }
            float o[4] = {0.f, 0.f, 0.f, 0.f};
#pragma unroll
            for (int i = 0; i < 8; ++i)
#pragma unroll
                for (int c = 0; c < 4; ++c) { S4[i][c] = f[i] * S4[i][c] + k[i] * v[c]; o[c] += q[i] * S4[i][c]; }
#pragma unroll
            for (int c = 0; c < 4; ++c) { o[c] = dpp_rr_add(o[c]); o[c] += __shfl_xor(o[c], 16); o[c] += __shfl_xor(o[c], 32); }
            if (dq == 0) *(LAS f32x4*)(Os + t * 128 + vcol) = (f32x4){o[0], o[1], o[2], o[3]};
        }
        __syncthreads();
        if (tid < 64) {
            float x[16]; float ssum = 0.f;
#pragma unroll
            for (int i = 0; i < 4; ++i) { const f32x4 t = *(const LAS f32x4*)(Os + er * 128 + eseg * 16 + 4 * i); x[4 * i] = t[0]; x[4 * i + 1] = t[1]; x[4 * i + 2] = t[2]; x[4 * i + 3] = t[3]; ssum += (t[0] * t[0] + t[1] * t[1]) + (t[2] * t[2] + t[3] * t[3]); }
            ssum += __shfl_xor(ssum, 1); ssum += __shfl_xor(ssum, 2); ssum += __shfl_xor(ssum, 4);
            const float rstd = rsqrtf(ssum * (1.0f / 128.0f) + EPS);
            const unsigned gu[8] = {g0.x, g0.y, g0.z, g0.w, g1.x, g1.y, g1.z, g1.w};
            unsigned ou[8];
#pragma unroll
            for (int i = 0; i < 8; ++i) { const float a = x[2 * i] * rstd * nw[2 * i] * bflo(gu[i]), b = x[2 * i + 1] * rstd * nw[2 * i + 1] * bfhi(gu[i]); ou[i] = cvtpk(a, b); }
            bf16* op = OB + (row0 + er) * D + colo + eseg * 16;
            *(v4u*)op = (v4u){ou[0], ou[1], ou[2], ou[3]}; *(v4u*)(op + 8) = (v4u){ou[4], ou[5], ou[6], ou[7]};
        }
        {   float* sout = so + (size_t)(bs * 4 + h) * 16384;
#pragma unroll
            for (int i = 0; i < 8; ++i) { const int p = 8 * dq + i, d = HG ? p : ((p >> 1) + 64 * (p & 1)); *(f32x4*)(sout + (size_t)d * 128 + vcol) = S4[i]; } }
        tq = nq; tk = nk; tv = nv; g0 = n0; g1 = n1;
#pragma unroll
        for (int i = 0; i < 8; ++i) S4[i] = N4[i];
    }
#undef RU8_ISSUE
}

typedef short bf16x8 __attribute__((ext_vector_type(8)));
constexpr int QS_STRIDE = 144, TS_STRIDE = 80, OS_STRIDE = 132;
constexpr int L_QS = 0, L_KS = 18432, L_KT = 36864, L_VT = 57344, L_PS = 77824, L_OS = 88064, L_ES = 121856, L_FS = 122368;
#define MFMA16(a, b, c) __builtin_amdgcn_mfma_f32_16x16x32_bf16((a), (b), (c), 0, 0, 0)
template <bool HG>
__device__ __forceinline__ void chunk_unit(LAS unsigned char* lds, const bf16* proj, const bf16* qkb, const int qks, bf16* OB, const float* normw, const float* ef, size_t row0, int nchunks, int h, float* s_out, const float* sl_base, const float* dl_base, int nseg, int tid) {
    const int w = __builtin_amdgcn_readfirstlane(tid >> 6), lane = tid & 63, n = lane & 15, g = lane >> 4;
    const int lr = 8 * w + g, lc = 8 * n;
    const int colq = 128 * h, colk = colq + 512, colv = (HG ? 2048 : 0) + 128 * h + 1024, colg = colv + 512, colo = (HG ? 512 : 0) + 128 * h;
    LAS bf16* Qs = (LAS bf16*)(lds + L_QS); LAS bf16* Ks = (LAS bf16*)(lds + L_KS); LAS bf16* Kt = (LAS bf16*)(lds + L_KT); LAS bf16* Vt = (LAS bf16*)(lds + L_VT);
    LAS bf16* Ps = (LAS bf16*)(lds + L_PS); LAS float* Os = (LAS float*)(lds + L_OS); LAS float* Es = (LAS float*)(lds + L_ES); LAS float* Fs = (LAS float*)(lds + L_FS);
    const float l2g = log2gamma(h);
    f32x4 S[8];
#pragma unroll
    for (int j = 0; j < 8; ++j) S[j] = (f32x4){0.f, 0.f, 0.f, 0.f};
    {   const float g512 = exp2f(512.0f * l2g);
        for (int s2 = 0; s2 < nseg; ++s2) {
            const float* sp = sl_base + (size_t)s2 * 16384 + tid; const float* dp = dl_base + (size_t)s2 * 16384 + tid;
#pragma unroll
            for (int j = 0; j < 8; ++j)
#pragma unroll
                for (int i = 0; i < 4; ++i) { const float sv = sp[(j * 4 + i) * 512]; const float dv = HG ? dp[(j * 4 + i) * 512] : g512; S[j][i] = dv * S[j][i] + sv; }
        } }
    v4u rq[2], rk[2], rv[2], rg[2], nq[2], nk[2], nv[2], ng[2];
    f32x4 ref = (f32x4){0.f, 0.f, 0.f, 0.f}, nref = ref;
    {   const bf16* src = proj + (row0 + lr) * NIN + lc; const bf16* sqk = qkb + (row0 + lr) * qks + lc;
#pragma unroll
        for (int pc = 0; pc < 2; ++pc) { rq[pc] = *(const v4u*)(sqk + (size_t)(4 * pc) * qks + colq); rk[pc] = *(const v4u*)(sqk + (size_t)(4 * pc) * qks + colk); rv[pc] = *(const v4u*)(src + (size_t)(4 * pc) * NIN + colv);
            nq[pc] = *(const v4u*)(sqk + (size_t)(64 + 4 * pc) * qks + colq); nk[pc] = *(const v4u*)(sqk + (size_t)(64 + 4 * pc) * qks + colk); nv[pc] = *(const v4u*)(src + (size_t)(64 + 4 * pc) * NIN + colv); }
        if (HG) { if (tid < 64) { ref = *(const f32x4*)(ef + 4 * tid); nref = *(const f32x4*)(ef + 256 + 4 * tid); } } }
    const int er = tid >> 3, eseg = tid & 7;
    { const bf16* gp = proj + (row0 + er) * NIN + colg + eseg * 16; rg[0] = *(const v4u*)gp; rg[1] = *(const v4u*)(gp + 8); }
    float nw[16];
#pragma unroll
    for (int i = 0; i < 16; ++i) nw[i] = normw[eseg * 16 + i];
    float rs[16];
#pragma unroll
    for (int i = 0; i < 16; ++i) rs[i] = HG ? 1.0f : exp2f((float)(16 * (i >> 2) + 4 * g + (i & 3) + 1) * l2g);
    const float f64 = exp2f(64.0f * l2g);
    for (int c = 0; c < nchunks; ++c) {
        const size_t crow = row0 + (size_t)c * 64;
#pragma unroll
        for (int pc = 0; pc < 2; ++pc) {
            const int r = lr + 4 * pc;
            *(LAS v4u*)(Qs + r * QS_STRIDE + lc) = rq[pc];
            *(LAS v4u*)(Ks + r * QS_STRIDE + lc) = rk[pc];
            const unsigned ku[4] = {rk[pc].x, rk[pc].y, rk[pc].z, rk[pc].w}, vu[4] = {rv[pc].x, rv[pc].y, rv[pc].z, rv[pc].w};
            const int tcol = ((w ^ (n & 7)) << 3) + g + 4 * pc;
#pragma unroll
            for (int i = 0; i < 8; ++i) { Kt[(lc + i) * TS_STRIDE + tcol] = (bf16)(ku[i >> 1] >> (16 * (i & 1))); Vt[(lc + i) * TS_STRIDE + tcol] = (bf16)(vu[i >> 1] >> (16 * (i & 1))); }
        }
        if (HG) { if (tid < 64) *(LAS f32x4*)(Es + 4 * tid) = ref; }
        __syncthreads();
        v4u fq[2], fk[2], fv[2]; f32x4 fref = (f32x4){0.f, 0.f, 0.f, 0.f};
#pragma unroll
        for (int pc = 0; pc < 2; ++pc) { fq[pc] = nq[pc]; fk[pc] = nk[pc]; fv[pc] = nv[pc]; }
        ng[0] = rg[0]; ng[1] = rg[1];
        if (c + 2 < nchunks) { const bf16* src = proj + (crow + 128 + lr) * NIN + lc; const bf16* sqk = qkb + (crow + 128 + lr) * qks + lc;
#pragma unroll
            for (int pc = 0; pc < 2; ++pc) { fq[pc] = *(const v4u*)(sqk + (size_t)(4 * pc) * qks + colq); fk[pc] = *(const v4u*)(sqk + (size_t)(4 * pc) * qks + colk); fv[pc] = *(const v4u*)(src + (size_t)(4 * pc) * NIN + colv); }
            if (HG) { if (tid < 64) fref = *(const f32x4*)(ef + (size_t)(c + 2) * 256 + 4 * tid); } }
        if (c + 1 < nchunks) { const bf16* gp = proj + (crow + 64 + er) * NIN + colg + eseg * 16; ng[0] = *(const v4u*)gp; ng[1] = *(const v4u*)(gp + 8); }
        {   const int I = w >> 1;
#pragma unroll
            for (int jj = 0; jj < 2; ++jj) {
                const int J = 2 * (w & 1) + jj;
                f32x4 a4 = (f32x4){0.f, 0.f, 0.f, 0.f};
                if (J <= I) {
#pragma unroll
                    for (int kk = 0; kk < 4; ++kk) {
                        const bf16x8 ka = *(const LAS bf16x8*)(Ks + (16 * J + n) * QS_STRIDE + 32 * kk + 8 * g);
                        const bf16x8 qb = *(const LAS bf16x8*)(Qs + (16 * I + n) * QS_STRIDE + 32 * kk + 8 * g);
                        a4 = MFMA16(ka, qb, a4);
                    }
                    if (J == I) {
#pragma unroll
                        for (int i = 0; i < 4; ++i) if (4 * g + i > n) a4[i] = 0.f;
                    }
                }
                *(LAS v2u*)(Ps + (16 * I + n) * TS_STRIDE + 16 * J + 4 * g) = (v2u){cvtpk(a4[0], a4[1]), cvtpk(a4[2], a4[3])};
            }
        }
        f32x4 O[4];
#pragma unroll
        for (int I = 0; I < 4; ++I) O[I] = (f32x4){0.f, 0.f, 0.f, 0.f};
        {
            if (HG) {
#pragma unroll
                for (int j = 0; j < 8; ++j) S[j] *= *(const LAS f32x4*)(Es + 16 * j + 4 * g);
            }
            bf16x8 sb[4];
#pragma unroll
            for (int kk = 0; kk < 4; ++kk) sb[kk] = __builtin_bit_cast(bf16x8, (v4u){cvtpk(S[2 * kk][0], S[2 * kk][1]), cvtpk(S[2 * kk][2], S[2 * kk][3]), cvtpk(S[2 * kk + 1][0], S[2 * kk + 1][1]), cvtpk(S[2 * kk + 1][2], S[2 * kk + 1][3])});
            __builtin_amdgcn_s_setprio(1);
#pragma unroll
            for (int I = 0; I < 4; ++I)
#pragma unroll
                for (int kk = 0; kk < 4; ++kk) {
                    const v2u lo = *(const LAS v2u*)(Qs + (16 * I + n) * QS_STRIDE + 32 * kk + 4 * g), hi = *(const LAS v2u*)(Qs + (16 * I + n) * QS_STRIDE + 32 * kk + 16 + 4 * g);
                    O[I] = MFMA16(__builtin_bit_cast(bf16x8, (v4u){lo.x, lo.y, hi.x, hi.y}), sb[kk], O[I]);
                }
            __builtin_amdgcn_s_setprio(0);
        }
        __syncthreads();
        {
            bf16x8 vb[2];
#pragma unroll
            for (int kk = 0; kk < 2; ++kk) vb[kk] = *(const LAS bf16x8*)(Vt + (16 * w + n) * TS_STRIDE + (((4 * kk + g) ^ ((2 * w + (n >> 3)) & 7)) << 3));
            __builtin_amdgcn_s_setprio(1);
#pragma unroll
            for (int I = 0; I < 4; ++I)
#pragma unroll
                for (int kk = 0; kk < 2; ++kk) O[I] = MFMA16(*(const LAS bf16x8*)(Ps + (16 * I + n) * TS_STRIDE + 32 * kk + 8 * g), vb[kk], O[I]);
#pragma unroll
            for (int j = 0; j < 8; ++j)
#pragma unroll
                for (int kk = 0; kk < 2; ++kk) S[j] = MFMA16(*(const LAS bf16x8*)(Kt + (16 * j + n) * TS_STRIDE + (((4 * kk + g) ^ ((2 * j + (n >> 3)) & 7)) << 3)), vb[kk], S[j]);
            __builtin_amdgcn_s_setprio(0);
            if (HG) {
#pragma unroll
                for (int j = 0; j < 8; ++j) S[j] *= *(const LAS f32x4*)(Fs + 16 * j + 4 * g);
            } else {
#pragma unroll
                for (int j = 0; j < 8; ++j) S[j] *= f64;
            }
        }
#pragma unroll
        for (int I = 0; I < 4; ++I)
#pragma unroll
            for (int i = 0; i < 4; ++i) { const int t = 16 * I + 4 * g + i; Os[t * OS_STRIDE + 16 * w + n] = HG ? O[I][i] : O[I][i] * rs[4 * I + i]; }
        __syncthreads();
        {
            float x[16]; float s = 0.f;
#pragma unroll
            for (int i = 0; i < 4; ++i) { const f32x4 t = *(const LAS f32x4*)(Os + er * OS_STRIDE + eseg * 16 + 4 * i); x[4 * i] = t[0]; x[4 * i + 1] = t[1]; x[4 * i + 2] = t[2]; x[4 * i + 3] = t[3]; s += (t[0] * t[0] + t[1] * t[1]) + (t[2] * t[2] + t[3] * t[3]); }
            s += __shfl_xor(s, 1); s += __shfl_xor(s, 2); s += __shfl_xor(s, 4);
            const float rstd = rsqrtf(s * (1.0f / 128.0f) + EPS);
            const unsigned gu[8] = {rg[0].x, rg[0].y, rg[0].z, rg[0].w, rg[1].x, rg[1].y, rg[1].z, rg[1].w};
            unsigned ou[8];
#pragma unroll
            for (int i = 0; i < 8; ++i) { const float a = x[2 * i] * rstd * nw[2 * i] * bflo(gu[i]), b = x[2 * i + 1] * rstd * nw[2 * i + 1] * bfhi(gu[i]); ou[i] = cvtpk(a, b); }
            bf16* op = OB + (crow + er) * D + colo + eseg * 16;
            *(v4u*)op = (v4u){ou[0], ou[1], ou[2], ou[3]}; *(v4u*)(op + 8) = (v4u){ou[4], ou[5], ou[6], ou[7]};
        }
#pragma unroll
        for (int pc = 0; pc < 2; ++pc) { rq[pc] = nq[pc]; rk[pc] = nk[pc]; rv[pc] = nv[pc]; nq[pc] = fq[pc]; nk[pc] = fk[pc]; nv[pc] = fv[pc]; }
        rg[0] = ng[0]; rg[1] = ng[1]; ref = nref; nref = fref;
    }
    if (s_out) {
#pragma unroll
    for (int j = 0; j < 8; ++j)
#pragma unroll
        for (int i = 0; i < 4; ++i) { const int p = 16 * j + 4 * g + i, d = HG ? p : ((p >> 1) + 64 * (p & 1)); __builtin_nontemporal_store(S[j][i], s_out + (size_t)d * 128 + 16 * w + n); }
    }
    __syncthreads();
}

template <bool HG>
__device__ __forceinline__ void state_unit(LAS unsigned char* lds, const bf16* proj, const bf16* qkb, const int qks, const float* ef, size_t row0, int nchunks, int h, float* sl_out, float* dl_out, int tid) {
    const int w = __builtin_amdgcn_readfirstlane(tid >> 6), lane = tid & 63, n = lane & 15, g = lane >> 4;
    const int lr = 8 * w + g, lc = 8 * n;
    const int colk = 128 * h + 512, colv = (HG ? 2048 : 0) + 128 * h + 1024;
    LAS bf16* Kt = (LAS bf16*)(lds + L_KT); LAS bf16* Vt = (LAS bf16*)(lds + L_VT); LAS float* Es = (LAS float*)(lds + L_ES); LAS float* Fs = (LAS float*)(lds + L_FS);
    const float f64 = exp2f(64.0f * log2gamma(h));
    f32x4 S[8], Dt[8];
#pragma unroll
    for (int j = 0; j < 8; ++j) { S[j] = (f32x4){0.f, 0.f, 0.f, 0.f}; Dt[j] = (f32x4){1.f, 1.f, 1.f, 1.f}; }
    v4u rk[2], rv[2], nk[2], nv[2]; f32x4 ref = (f32x4){0.f, 0.f, 0.f, 0.f}, nref = ref;
    {   const bf16* src = proj + (row0 + lr) * NIN + lc; const bf16* sqk = qkb + (row0 + lr) * qks + lc;
#pragma unroll
        for (int pc = 0; pc < 2; ++pc) { rk[pc] = *(const v4u*)(sqk + (size_t)(4 * pc) * qks + colk); rv[pc] = *(const v4u*)(src + (size_t)(4 * pc) * NIN + colv); }
        if (HG) { if (tid < 64) ref = *(const f32x4*)(ef + 4 * tid); } }
    for (int c = 0; c < nchunks; ++c) {
        const size_t crow = row0 + (size_t)c * 64;
#pragma unroll
        for (int pc = 0; pc < 2; ++pc) { nk[pc] = rk[pc]; nv[pc] = rv[pc]; }
        nref = ref;
        if (c + 1 < nchunks) { const bf16* src = proj + (crow + 64 + lr) * NIN + lc; const bf16* sqk = qkb + (crow + 64 + lr) * qks + lc;
#pragma unroll
            for (int pc = 0; pc < 2; ++pc) { nk[pc] = *(const v4u*)(sqk + (size_t)(4 * pc) * qks + colk); nv[pc] = *(const v4u*)(src + (size_t)(4 * pc) * NIN + colv); }
            if (HG) { if (tid < 64) nref = *(const f32x4*)(ef + (size_t)(c + 1) * 256 + 4 * tid); } }
#pragma unroll
        for (int pc = 0; pc < 2; ++pc) {
            const unsigned ku[4] = {rk[pc].x, rk[pc].y, rk[pc].z, rk[pc].w}, vu[4] = {rv[pc].x, rv[pc].y, rv[pc].z, rv[pc].w};
            const int tcol = ((w ^ (n & 7)) << 3) + g + 4 * pc;
#pragma unroll
            for (int i = 0; i < 8; ++i) { Kt[(lc + i) * TS_STRIDE + tcol] = (bf16)(ku[i >> 1] >> (16 * (i & 1))); Vt[(lc + i) * TS_STRIDE + tcol] = (bf16)(vu[i >> 1] >> (16 * (i & 1))); }
        }
        if (HG) { if (tid < 64) *(LAS f32x4*)(Es + 4 * tid) = ref; }
        __syncthreads();
        {
            if (HG) {
#pragma unroll
                for (int j = 0; j < 8; ++j) { const f32x4 e4 = *(const LAS f32x4*)(Es + 16 * j + 4 * g), f4 = *(const LAS f32x4*)(Fs + 16 * j + 4 * g); S[j] *= e4; Dt[j] *= e4 * f4; }
            }
            bf16x8 vb[2];
#pragma unroll
            for (int kk = 0; kk < 2; ++kk) vb[kk] = *(const LAS bf16x8*)(Vt + (16 * w + n) * TS_STRIDE + (((4 * kk + g) ^ ((2 * w + (n >> 3)) & 7)) << 3));
            __builtin_amdgcn_s_setprio(1);
#pragma unroll
            for (int j = 0; j < 8; ++j)
#pragma unroll
                for (int kk = 0; kk < 2; ++kk) S[j] = MFMA16(*(const LAS bf16x8*)(Kt + (16 * j + n) * TS_STRIDE + (((4 * kk + g) ^ ((2 * j + (n >> 3)) & 7)) << 3)), vb[kk], S[j]);
            __builtin_amdgcn_s_setprio(0);
            if (HG) {
#pragma unroll
                for (int j = 0; j < 8; ++j) S[j] *= *(const LAS f32x4*)(Fs + 16 * j + 4 * g);
            } else {
#pragma unroll
                for (int j = 0; j < 8; ++j) S[j] *= f64;
            }
        }
        __syncthreads();
#pragma unroll
        for (int pc = 0; pc < 2; ++pc) { rk[pc] = nk[pc]; rv[pc] = nv[pc]; }
        ref = nref;
    }
#pragma unroll
    for (int j = 0; j < 8; ++j)
#pragma unroll
        for (int i = 0; i < 4; ++i) { sl_out[(j * 4 + i) * 512 + tid] = S[j][i]; if (HG) dl_out[(j * 4 + i) * 512 + tid] = Dt[j][i]; }
}


constexpr int M8_QS = 0, M8_KS = 4608, M8_KT = 9216, M8_VT = 11264, M8_FS = 13312, M8_OS = 13824;
template <bool HG>
__device__ __forceinline__ void mf_units8(LAS unsigned char* lds, const bf16* proj, bf16* OB, const float* normw, const float* st, float* so, int u0, int ustep, int uend, int h, int tid) {
    const int w = __builtin_amdgcn_readfirstlane(tid >> 6), lane = tid & 63, n = lane & 15, g = lane >> 4;
    const int colq = (HG ? 2048 : 0) + 128 * h, colk = colq + 512, colv = colq + 1024, colg = colq + 1536, colo = (HG ? 512 : 0) + 128 * h;
    LAS bf16* Qs = (LAS bf16*)(lds + M8_QS); LAS bf16* Ks = (LAS bf16*)(lds + M8_KS); LAS bf16* Kt = (LAS bf16*)(lds + M8_KT); LAS bf16* Vt = (LAS bf16*)(lds + M8_VT);
    LAS float* Fs = (LAS float*)(lds + M8_FS); LAS float* Os = (LAS float*)(lds + M8_OS);
    const int er = tid >> 3, eseg = tid & 7;
    const int tr = lane >> 3, tc = lane & 7;
    const float l2g = log2gamma(h);
    float nw[16];
#pragma unroll
    for (int i = 0; i < 16; ++i) nw[i] = normw[eseg * 16 + i];
    __syncthreads();
    for (int i = tid; i < 2 * 8 * 144 / 2; i += NTHR) { ((LAS unsigned*)(Qs + 8 * 144))[i % (8 * 144 / 2)] = 0u; ((LAS unsigned*)(Ks + 8 * 144))[i % (8 * 144 / 2)] = 0u; }
    for (int u = u0; u < uend; u += ustep) {
        const int bs = u >> 3; const size_t row0 = (size_t)NP + (size_t)bs * 8;
        const float* sin = st + (size_t)(bs * 4 + h) * 16384; float* sout = so + (size_t)(bs * 4 + h) * 16384;
        v4u tq[2], tk[2], tv[2], g0 = (v4u){0u, 0u, 0u, 0u}, g1 = g0;
#pragma unroll
        for (int pc = 0; pc < 2; ++pc) { tq[pc] = g0; tk[pc] = g0; tv[pc] = g0; }
        if (w == 0) {
            const bf16* src = proj + (row0 + tr) * NIN + 8 * tc;
#pragma unroll
            for (int pc = 0; pc < 2; ++pc) { tq[pc] = *(const v4u*)(src + colq + 64 * pc); tk[pc] = *(const v4u*)(src + colk + 64 * pc); tv[pc] = *(const v4u*)(src + colv + 64 * pc); }
            const bf16* gp = proj + (row0 + er) * NIN + colg + eseg * 16; g0 = *(const v4u*)gp; g1 = *(const v4u*)(gp + 8);
        }
        f32x4 S[8];
#pragma unroll
        for (int j = 0; j < 8; ++j)
#pragma unroll
            for (int i = 0; i < 4; ++i) { const int p = 16 * j + 4 * g + i, d = HG ? p : ((p >> 1) + 64 * (p & 1)); S[j][i] = __builtin_nontemporal_load(sin + (size_t)d * 128 + 16 * w + n); }
        __syncthreads();
        if (w == 0) {
#pragma unroll
            for (int pc = 0; pc < 2; ++pc) {
                const int cc = tc + 8 * pc;
                const unsigned qu[4] = {tq[pc].x, tq[pc].y, tq[pc].z, tq[pc].w}, ku[4] = {tk[pc].x, tk[pc].y, tk[pc].z, tk[pc].w};
                float qp[8], kp[8];
#pragma unroll
                for (int i = 0; i < 8; ++i) {
                    const float q = (i & 1) ? bfhi(qu[i >> 1]) : bflo(qu[i >> 1]), kx = (i & 1) ? bfhi(ku[i >> 1]) : bflo(ku[i >> 1]);
                    if (HG) {
                        float b = kx;
                        { const float t1 = __shfl_up(b, 8); if (lane >= 8) b += t1; const float t2 = __shfl_up(b, 16); if (lane >= 16) b += t2; const float t3 = __shfl_up(b, 32); if (lane >= 32) b += t3; }
                        const float b7 = __shfl(b, 56 + tc);
                        qp[i] = q * __expf(b); kp[i] = (1.0f - __expf(kx)) * __expf(fminf(-b, 80.f));
                        if (tr == 7) Fs[8 * cc + i] = __expf(b7);
                    } else { qp[i] = q; kp[i] = kx * exp2f(-(float)(tr + 1) * l2g); }
                }
                const v4u qo = (v4u){cvtpk(qp[0], qp[1]), cvtpk(qp[2], qp[3]), cvtpk(qp[4], qp[5]), cvtpk(qp[6], qp[7])};
                const v4u ko = (v4u){cvtpk(kp[0], kp[1]), cvtpk(kp[2], kp[3]), cvtpk(kp[4], kp[5]), cvtpk(kp[6], kp[7])};
                *(LAS v4u*)(Qs + tr * 144 + 8 * cc) = qo; *(LAS v4u*)(Ks + tr * 144 + 8 * cc) = ko;
                const unsigned kw[4] = {ko.x, ko.y, ko.z, ko.w}, vw[4] = {tv[pc].x, tv[pc].y, tv[pc].z, tv[pc].w};
#pragma unroll
                for (int i = 0; i < 8; ++i) { Kt[(8 * cc + i) * 8 + tr] = (bf16)(kw[i >> 1] >> (16 * (i & 1))); Vt[(8 * cc + i) * 8 + tr] = (bf16)(vw[i >> 1] >> (16 * (i & 1))); }
            }
        }
        __syncthreads();
        f32x4 a4 = (f32x4){0.f, 0.f, 0.f, 0.f};
#pragma unroll
        for (int kk = 0; kk < 4; ++kk) a4 = MFMA16(*(const LAS bf16x8*)(Ks + n * 144 + 32 * kk + 8 * g), *(const LAS bf16x8*)(Qs + n * 144 + 32 * kk + 8 * g), a4);
#pragma unroll
        for (int i = 0; i < 4; ++i) if (4 * g + i > n) a4[i] = 0.f;
        const bf16x8 pa = __builtin_bit_cast(bf16x8, (v4u){cvtpk(a4[0], a4[1]), cvtpk(a4[2], a4[3]), 0u, 0u});
        v2u vraw = (v2u){0u, 0u};
        if (g < 2) vraw = *(const LAS v2u*)(Vt + (16 * w + n) * 8 + 4 * g);
        const bf16x8 vb = __builtin_bit_cast(bf16x8, (v4u){vraw.x, vraw.y, 0u, 0u});
        f32x4 O = MFMA16(pa, vb, ((f32x4){0.f, 0.f, 0.f, 0.f}));
#pragma unroll
        for (int kk = 0; kk < 4; ++kk) {
            const bf16x8 sb = __builtin_bit_cast(bf16x8, (v4u){cvtpk(S[2 * kk][0], S[2 * kk][1]), cvtpk(S[2 * kk][2], S[2 * kk][3]), cvtpk(S[2 * kk + 1][0], S[2 * kk + 1][1]), cvtpk(S[2 * kk + 1][2], S[2 * kk + 1][3])});
            const v2u lo = *(const LAS v2u*)(Qs + n * 144 + 32 * kk + 4 * g), hi = *(const LAS v2u*)(Qs + n * 144 + 32 * kk + 16 + 4 * g);
            O = MFMA16(__builtin_bit_cast(bf16x8, (v4u){lo.x, lo.y, hi.x, hi.y}), sb, O);
        }
#pragma unroll
        for (int j = 0; j < 8; ++j) {
            v2u kraw = (v2u){0u, 0u};
            if (g < 2) kraw = *(const LAS v2u*)(Kt + (16 * j + n) * 8 + 4 * g);
            S[j] = MFMA16(__builtin_bit_cast(bf16x8, (v4u){kraw.x, kraw.y, 0u, 0u}), vb, S[j]);
            if (HG) S[j] *= *(const LAS f32x4*)(Fs + 16 * j + 4 * g); else S[j] *= exp2f(8.0f * l2g);
        }
        if (g < 2) {
#pragma unroll
            for (int i = 0; i < 4; ++i) { const int t = 4 * g + i; Os[t * OS_STRIDE + 16 * w + n] = HG ? O[i] : O[i] * exp2f((float)(t + 1) * l2g); }
        }
        __syncthreads();
        if (tid < 64) {
            float x[16]; float ssum = 0.f;
#pragma unroll
            for (int i = 0; i < 4; ++i) { const f32x4 t = *(const LAS f32x4*)(Os + er * OS_STRIDE + eseg * 16 + 4 * i); x[4 * i] = t[0]; x[4 * i + 1] = t[1]; x[4 * i + 2] = t[2]; x[4 * i + 3] = t[3]; ssum += (t[0] * t[0] + t[1] * t[1]) + (t[2] * t[2] + t[3] * t[3]); }
            ssum += __shfl_xor(ssum, 1); ssum += __shfl_xor(ssum, 2); ssum += __shfl_xor(ssum, 4);
            const float rstd = rsqrtf(ssum * (1.0f / 128.0f) + EPS);
            const unsigned gu[8] = {g0.x, g0.y, g0.z, g0.w, g1.x, g1.y, g1.z, g1.w};
            unsigned ou[8];
#pragma unroll
            for (int i = 0; i < 8; ++i) { const float a = x[2 * i] * rstd * nw[2 * i] * bflo(gu[i]), b = x[2 * i + 1] * rstd * nw[2 * i + 1] * bfhi(gu[i]); ou[i] = cvtpk(a, b); }
            bf16* op = OB + (row0 + er) * D + colo + eseg * 16;
            *(v4u*)op = (v4u){ou[0], ou[1], ou[2], ou[3]}; *(v4u*)(op + 8) = (v4u){ou[4], ou[5], ou[6], ou[7]};
        }
#pragma unroll
        for (int j = 0; j < 8; ++j)
#pragma unroll
            for (int i = 0; i < 4; ++i) { const int p = 16 * j + 4 * g + i, d = HG ? p : ((p >> 1) + 64 * (p & 1)); __builtin_nontemporal_store(S[j][i], sout + (size_t)d * 128 + 16 * w + n); }
    }
    __syncthreads();
}

#define XB_TMO      128
#define XB_XCNT(j)  (256  + 64 * (j))
#define XB_XSUB(j)  (1280 + 64 * (j))
#define XB_XGEN(j)  (2304 + 64 * (j))
#define XB_TOP      3328
#define XB_TOPGEN   3392
#define XCD_BAR_WORDS 3456
#define XB_SPIN_CAP (1u << 18)

__device__ __forceinline__ unsigned xb_ld(unsigned* p)              { return __hip_atomic_load(p, __ATOMIC_RELAXED, __HIP_MEMORY_SCOPE_AGENT); }
__device__ __forceinline__ unsigned xb_add(unsigned* p, unsigned v) { return __hip_atomic_fetch_add(p, v, __ATOMIC_RELAXED, __HIP_MEMORY_SCOPE_AGENT); }
__device__ __forceinline__ unsigned xb_xcc_id() { return (unsigned)__builtin_amdgcn_s_getreg((3 << 11) | 20) & 0xFu; }
#define XB_SPIN(cond, bar) do { unsigned _sp = 0; while (cond) { __builtin_amdgcn_s_sleep(1); \
    if ((++_sp & 255u) == 0u) { if (xb_ld(&(bar)[XB_TMO])) break; if (_sp > XB_SPIN_CAP) { atomicAdd(&(bar)[XB_TMO], 1u); break; } } } } while (0)

struct XcdBarrier {
    unsigned* bar; unsigned x;
    volatile LAS unsigned* st;
};

__device__ __forceinline__ XcdBarrier xcd_barrier_post(unsigned* bar, volatile LAS unsigned* st) {
    XcdBarrier b; b.bar = bar; b.x = xb_xcc_id(); b.st = st;
    if (threadIdx.x == 0) (void)xb_add(&bar[XB_XCNT(b.x)], 1u);
    return b;
}
__device__ __forceinline__ void xcd_barrier_complete(unsigned* bar, unsigned x, unsigned& nloc, unsigned& nx) {
    const unsigned G = gridDim.x * gridDim.y * gridDim.z;
    unsigned sum, cnt, mine, sp = 0u;
    for (;;) {
        sum = 0u; cnt = 0u; mine = 0u;
#pragma unroll
        for (unsigned j = 0; j < 16; ++j) { const unsigned c = xb_ld(&bar[XB_XCNT(j)]); sum += c; cnt += (c > 0u) ? 1u : 0u; mine = (j == x) ? c : mine; }
        if (sum == G) break;
        __builtin_amdgcn_s_sleep(1);
        if ((++sp & 255u) == 0u) { if (xb_ld(&bar[XB_TMO])) break; if (sp > XB_SPIN_CAP) { atomicAdd(&bar[XB_TMO], 1u); break; } }
    }
    nloc = mine > 0u ? mine : 1u; nx = cnt > 0u ? cnt : 1u;
}

__device__ __forceinline__ void xcd_barrier(const XcdBarrier& b) {
    asm volatile("s_waitcnt vmcnt(0)" ::: "memory");
    __syncthreads();
    if (threadIdx.x == 0) {
        unsigned* bar = b.bar;
        __builtin_amdgcn_s_waitcnt(0);
        unsigned nloc = b.st[0], nx = b.st[1];
        if (nloc == 0u) { xcd_barrier_complete(bar, b.x, nloc, nx); b.st[0] = nloc; b.st[1] = nx; }
        const unsigned old = xb_add(&bar[XB_XSUB(b.x)], 1u);
        const unsigned gen = old / nloc;
        if (old + 1u == (gen + 1u) * nloc) {
            __builtin_amdgcn_fence(__ATOMIC_RELEASE, "agent");
            asm volatile("s_waitcnt vmcnt(0)" ::: "memory");
            const unsigned og = xb_add(&bar[XB_TOP], 1u);
            const unsigned tg = og / nx;
            if (og + 1u == (tg + 1u) * nx) xb_add(&bar[XB_TOPGEN], 1u);
            else XB_SPIN(xb_ld(&bar[XB_TOPGEN]) == tg, bar);
            __builtin_amdgcn_fence(__ATOMIC_ACQUIRE, "agent");
            xb_add(&bar[XB_XGEN(b.x)], 1u);
            asm volatile("s_waitcnt vmcnt(0)" ::: "memory");
        } else {
            XB_SPIN(xb_ld(&bar[XB_XGEN(b.x)]) == gen, bar);
            __builtin_amdgcn_fence(__ATOMIC_ACQUIRE, "agent");
            asm volatile("s_waitcnt vmcnt(0)" ::: "memory");
        }
    }
    __syncthreads();
}

__device__ __forceinline__ void grid_seam(cg::grid_group& grid) {
#if defined(SEAM_HARD)
    __builtin_amdgcn_fence(__ATOMIC_RELEASE, "agent");
    asm volatile("s_waitcnt vmcnt(0)" ::: "memory");
#endif
    grid.sync();
#if defined(SEAM_HARD)
    __builtin_amdgcn_fence(__ATOMIC_ACQUIRE, "agent");
    asm volatile("s_waitcnt vmcnt(0)" ::: "memory");
#endif
}
struct Args { const float* in[14]; float* out; unsigned char* ws; int ph_lo, ph_hi, rep2, rep3; };
__global__ void __launch_bounds__(NTHR, 2) mega_fwd(Args a) {
    extern __shared__ __attribute__((aligned(16))) unsigned char lds_raw[];
    LAS unsigned char* lds = (LAS unsigned char*)lds_raw;
    cg::grid_group grid = cg::this_grid();
    const int wave = __builtin_amdgcn_readfirstlane((int)threadIdx.x >> 6);
#define lane ((int)__builtin_amdgcn_mbcnt_hi(~0u, __builtin_amdgcn_mbcnt_lo(~0u, 0u)))
#define tid (wave * 64 + lane)
    const int G = gridDim.x, bx = blockIdx.x;
    const float* x_p = a.in[0]; const float* x_s = a.in[1]; const float* st_ret = a.in[2]; const float* st_hg = a.in[3];
    const float* norm_mix_w = a.in[4]; const float* w_in = a.in[5]; const float* ret_norm_w = a.in[6]; const float* hg_norm_w = a.in[7];
    const float* lb_logits = a.in[8]; const float* w_out = a.in[9]; const float* norm_ffn_w = a.in[10]; const float* w_up = a.in[11]; const float* w_down = a.in[12];
    const float* final_norm_w = a.in[13];
    unsigned char* ws = a.ws; float* out = a.out;
    bf16* WinT = (bf16*)(ws + WS_WIN); bf16* WoutT = (bf16*)(ws + WS_WOUT); bf16* WupT = (bf16*)(ws + WS_WUP); bf16* WdnT = (bf16*)(ws + WS_WDN);
    float* tab = (float*)(ws + WS_TAB); float* ssq = (float*)(ws + WS_SSQ); float* EF = (float*)(ws + WS_EF); float* r2v = (float*)(ws + WS_SSQ + (size_t)M * 16 * 4 + 4096);
    float* SL = out + OUT_Y + (size_t)8 * 1024 * 1024;
    float* DL = SL + (size_t)64 * 3 * 16384;
    bf16* QKP = (bf16*)(out + OUT_Y);
    bf16* XN = (bf16*)(ws + WS_XN); bf16* PROJ = (bf16*)(ws + WS_PROJ); bf16* HB = (bf16*)(ws + WS_PROJ); bf16* OB = (bf16*)(ws + WS_OB);
    volatile LAS unsigned* xst = (volatile LAS unsigned*)(lds + 131072);
    if ((int)threadIdx.x < 16) xst[threadIdx.x] = 0u;
    __syncthreads();
    if (bx == 0) { v4u* cz = (v4u*)(ws + WS_CTL); for (int i = (int)threadIdx.x; i < (int)(CTL_BYTES / 16); i += NTHR) cz[i] = (v4u){0u, 0u, 0u, 0u}; }
    XcdBarrier xbar; xbar.bar = (unsigned*)(ws + WS_CTL); xbar.x = 0u; xbar.st = xst;
    const int lo = a.ph_lo, hi = a.ph_hi;
#define IN(k) (lo <= (k) && (k) < hi)
#define SEAM(k) do { if (IN(k) && IN((k) + 1)) { if ((k) == 0) grid_seam(grid); else xcd_barrier(xbar); } } while (0)

    if (IN(0)) {
        LAS float* scr = (LAS float*)(lds + wave * 16384);
        const int gw = bx * NWAVES + wave, NGW = G * NWAVES;
        constexpr int I_IN = (D / 64) * (NIN / 32);
        for (int it = gw; it < I_IN; it += NGW) p0_transpose_item<true>(w_in, D, NIN, WinT, nullptr, scr, it, lane);
        for (int m = gw; m < M; m += NGW) rms_row_to_bf16(m < NP ? x_p + (size_t)m * D : x_s + (size_t)(m - NP) * D, norm_mix_w, XN + (size_t)m * D, lane);
        for (int i = bx * NTHR + tid; i < (TP + 8) * 64; i += G * NTHR) {
            const int pi = i >> 6, j = i & 63; const double pos = (double)(pi < TP ? pi : 16384 + (pi - TP));
            double t = pos * INVF[j] * 0.15915494309189535; t -= __builtin_rint(t);
            tab[2 * i] = __builtin_amdgcn_cosf((float)t); tab[2 * i + 1] = __builtin_amdgcn_sinf((float)t);
        }
    }
    SEAM(0);
    xbar = xcd_barrier_post((unsigned*)(ws + WS_CTL), xst);
    if (IN(1)) for (int rep = 0; rep < NREP(1); ++rep) { if (rep) grid_seam(grid);
        pg8::Gemm g{XN, WinT, M, NIN, D}; pg8::StaticOrder S; S.init(M, NIN, G, bx, D);
        unsigned* hcnt = (unsigned*)(ws + WS_CTL) + 8192;
        EpiProj E{PROJ, tab, lb_logits, hcnt};
        pg8::gemm_phase<EpiProj, pg8::StaticOrder, true, true>(lds, g, S, E, tid);
        {
            constexpr int NFULL = ((M / 256) * (NIN / 256)) % 256;
            if (bx >= NFULL) {
                LAS float* scr = (LAS float*)(lds + wave * 16384);
                constexpr int I_OUT = (D / 64) * (D / 32);
                for (int it = (bx - NFULL) * NWAVES + wave; it < I_OUT; it += (G - NFULL) * NWAVES) p0_transpose_item<false>(w_out, D, D, WoutT, nullptr, scr, it, lane);
                if (threadIdx.x == 0) {
                    unsigned sp = 0u;
                    while (__hip_atomic_load(hcnt, __ATOMIC_RELAXED, __HIP_MEMORY_SCOPE_AGENT) < 256u) { __builtin_amdgcn_s_sleep(2); if (++sp > (1u << 22)) break; }
                    __builtin_amdgcn_fence(__ATOMIC_ACQUIRE, "agent");
                    asm volatile("s_waitcnt vmcnt(0)" ::: "memory");
                }
                __syncthreads();
                for (int bi = bx - NFULL; bi < 8 * 4 * 32; bi += G - NFULL) hg_prep_item2(PROJ, QKP, EF, bi * 16 + wave, bi * 16 + wave + 8, lane);
            }
        }
    }
    SEAM(1);
    if (IN(2)) {
        if (bx < 192) {
            const int stream = bx / 3, seg = bx - 3 * stream, b = stream >> 3, hd = stream & 7; const size_t row0 = (size_t)b * TP + (size_t)seg * 512;
            if (hd < 4) state_unit<false>(lds, PROJ, PROJ, NIN, nullptr, row0, 8, hd, SL + (size_t)(stream * 3 + seg) * 16384, nullptr, tid);
            else state_unit<true>(lds, PROJ, QKP, 1024, EF + ((size_t)(b * 4 + hd - 4) * 32 + seg * 8) * 256, row0, 8, hd - 4, SL + (size_t)(stream * 3 + seg) * 16384, DL + (size_t)((b * 4 + hd - 4) * 3 + seg) * 16384, tid);
            {
                const int u = 128 + bx, hs = u & 7;
                if (hs < 4) mf_units8<false>(lds, PROJ, OB, ret_norm_w, st_ret, out + OUT_RSS, u, 1024, 1024, hs, tid);
                else mf_units8<true>(lds, PROJ, OB, hg_norm_w, st_hg, out + OUT_HSS, u, 1024, 1024, hs - 4, tid);
            }
        } else {
            const int u0 = bx - 192, hs = u0 & 7;
            if (hs < 4) mf_units8<false>(lds, PROJ, OB, ret_norm_w, st_ret, out + OUT_RSS, u0, 64, 128, hs, tid);
            else mf_units8<true>(lds, PROJ, OB, hg_norm_w, st_hg, out + OUT_HSS, u0, 64, 128, hs - 4, tid);
        }
        xcd_barrier(xbar);
        {
            const int stream = bx >> 2, seg = bx & 3, b = stream >> 3, hd = stream & 7; const size_t row0 = (size_t)b * TP + (size_t)seg * 512;
            if (hd < 4) chunk_unit<false>(lds, PROJ, PROJ, NIN, OB, ret_norm_w, nullptr, row0, 8, hd, seg == 3 ? out + OUT_RSP + (size_t)(b * 4 + hd) * 16384 : nullptr, SL + (size_t)(stream * 3) * 16384, nullptr, seg, tid);
            else chunk_unit<true>(lds, PROJ, QKP, 1024, OB, hg_norm_w, EF + ((size_t)(b * 4 + hd - 4) * 32 + seg * 8) * 256, row0, 8, hd - 4, seg == 3 ? out + OUT_HSP + (size_t)(b * 4 + hd - 4) * 16384 : nullptr, SL + (size_t)(stream * 3) * 16384, DL + (size_t)((b * 4 + hd - 4) * 3) * 16384, seg, tid);
            {   const int u0 = 320 + (bx & 3) * 64 + (bx >> 2), hs = u0 & 7;
                if (hs < 4) mf_units8<false>(lds, PROJ, OB, ret_norm_w, st_ret, out + OUT_RSS, u0, 256, 1024, hs, tid);
                else mf_units8<true>(lds, PROJ, OB, hg_norm_w, st_hg, out + OUT_HSS, u0, 256, 1024, hs - 4, tid);
            }
        }
    }
    SEAM(2);
    if (IN(3)) for (int rep = 0; rep < NREP(3); ++rep) { if (rep) grid_seam(grid);
        pg8::Gemm g{OB, WoutT, M, D, D}; OutOrder S; S.init(G, bx);
        EpiOut E{x_p, x_s, out + OUT_Y, XN, ssq, (float*)(ws + WS_PROJ)};
        pg8::gemm_phase<EpiOut, OutOrder, true, true>(lds, g, S, E, tid);
        if (bx >= 16 * OUT_SPLIT) {
            LAS float* scr = (LAS float*)(lds + wave * 16384);
            constexpr int I_UP = (D / 64) * (FF / 32);
            for (int it = (bx - 16 * OUT_SPLIT) * NWAVES + wave; it < I_UP; it += (G - 16 * OUT_SPLIT) * NWAVES) p0_transpose_item<false>(w_up, D, FF, WupT, norm_ffn_w, scr, it, lane);
        }
    }
    SEAM(3);
    if (IN(4)) for (int rep = 0; rep < NREP(4); ++rep) { if (rep) grid_seam(grid);
        {
            const int gw = bx * NWAVES + wave, NGW = G * NWAVES;
            for (int m = gw; m < NS; m += NGW) sample_out_reduce(x_s + (size_t)m * D, (const float*)(ws + WS_PROJ) + (size_t)m * D, out + OUT_Y + (size_t)(NP + m) * D, XN + (size_t)(NP + m) * D, r2v + NP + m, lane);
            for (int r = bx * NTHR + tid; r < NP; r += G * NTHR) {
                const f32x4* sp = (const f32x4*)(ssq + (size_t)r * 16); const f32x4 a4 = sp[0], b4 = sp[1], c4 = sp[2], d4 = sp[3];
                const float ss = ((a4[0] + a4[1]) + (a4[2] + a4[3])) + ((b4[0] + b4[1]) + (b4[2] + b4[3])) + ((c4[0] + c4[1]) + (c4[2] + c4[3])) + ((d4[0] + d4[1]) + (d4[2] + d4[3]));
                r2v[r] = 1.0f / (ss * (1.0f / D) + EPS);
            }
            xcd_barrier(xbar);
        }
        pg8::Gemm g{XN, WupT, M, FF, D}; pg8::StaticOrder S; S.init(M, FF, G, bx, D);
        EpiUp E{HB, r2v};
        pg8::gemm_phase<EpiUp, pg8::StaticOrder, true, true>(lds, g, S, E, tid);
        {   constexpr int NFULL4 = ((M / 256) * (FF / 256)) % 256;
            if (bx >= NFULL4) {
                LAS float* scr = (LAS float*)(lds + wave * 16384);
                constexpr int I_DN = (FF / 64) * (D / 32);
                for (int it = (bx - NFULL4) * NWAVES + wave; it < I_DN; it += (G - NFULL4) * NWAVES) p0_transpose_item<false>(w_down, FF, D, WdnT, nullptr, scr, it, lane);
            }
        }
    }
    SEAM(4);
    if (IN(5)) {
        pg8::Gemm g{HB, WdnT, M, D, FF}; DownOrder S; S.init(G, bx);
        EpiDown E{XN, (float*)(ws + WS_OB)};
        pg8::gemm_phase<EpiDown, DownOrder, true, true>(lds, g, S, E, tid);
    }
    SEAM(5);
    if (IN(6)) {
        const int gw = bx * NWAVES + wave, NGW = G * NWAVES;
        for (int m = gw; m < NP; m += 2 * NGW) { const int m2 = m + NGW;
            rms_row2_from_bf16(XN + (size_t)m * D, out + OUT_Y + (size_t)m * D, m2 < NP ? XN + (size_t)m2 * D : nullptr, out + OUT_Y + (size_t)(m2 < NP ? m2 : m) * D, final_norm_w, lane); }
        for (int m = NP + gw; m < M; m += NGW) rms_row_inplace(out + OUT_Y + (size_t)m * D, final_norm_w, lane, (const float*)(ws + WS_OB) + (size_t)(m - NP) * D);
    }
#undef IN
#undef SEAM
#undef lane
#undef tid
}

extern "C" void kernel_launch(void* const* d_in, const int* in_sizes, int n_in, void* d_out, int out_size, void* d_ws, size_t ws_size, hipStream_t stream) {
    static int grid = 0;
    if (grid == 0) {
        if (n_in != 14 || in_sizes[0] != NP * D || ws_size < WS_END) { fprintf(stderr, "kernel_launch: unexpected shapes (n_in %d, in0 %d, ws %zu)\n", n_in, n_in > 0 ? in_sizes[0] : -1, ws_size); grid = -1; return; }
        int dev = 0, cus = 0, per_cu = 0;
        if (hipGetDevice(&dev) != hipSuccess || hipDeviceGetAttribute(&cus, hipDeviceAttributeMultiprocessorCount, dev) != hipSuccess) { grid = -1; return; }
        if (hipFuncSetAttribute((const void*)mega_fwd, hipFuncAttributeMaxDynamicSharedMemorySize, LDS_BYTES) != hipSuccess) { fprintf(stderr, "kernel_launch: hipFuncSetAttribute failed\n"); grid = -1; return; }
        if (hipOccupancyMaxActiveBlocksPerMultiprocessor(&per_cu, (const void*)mega_fwd, NTHR, LDS_BYTES) != hipSuccess || per_cu < 1) { fprintf(stderr, "kernel_launch: occupancy query says %d blocks per CU\n", per_cu); (void)hipGetLastError(); grid = -1; return; }
        grid = 256;
        if (cus * per_cu < 256) { fprintf(stderr, "kernel_launch: needs 256 co-resident workgroups; the device holds %d\n", cus * per_cu); grid = -1; return; }
    }
    if (grid < 0) return;
    Args a{};
    for (int i = 0; i < 14; ++i) a.in[i] = (const float*)d_in[i];
    a.out = (float*)d_out; a.ws = (unsigned char*)d_ws;
#ifndef PROBE_REP2
#define PROBE_REP2 1
#endif
#ifndef PROBE_REP3
#define PROBE_REP3 1
#endif
    a.ph_lo = 0; a.ph_hi = N_PHASES; a.rep2 = PROBE_REP2; a.rep3 = PROBE_REP3;
    void* args[] = {&a};
    hipError_t e = hipLaunchCooperativeKernel((const void*)mega_fwd, dim3(grid), dim3(NTHR), args, LDS_BYTES, stream);
    if (e != hipSuccess) fprintf(stderr, "cooperative launch failed: %s (grid %d)\n", hipGetErrorString(e), grid);
}
```
